# Optimizing an MI355X kernel written in HIP

```python
import jax, jax.numpy as jnp
from jax import lax
import numpy as np

D_MODEL = 1024
BATCH = 8
SEQ = 2048
DEPTH = 1
DEC_BATCH = 128
DEC_SEQ = 8
PAST_LEN = 16384
PAGE_SIZE = 128

D_CONF = D_MODEL
CONF_K = 31
D_RNN = 5 * D_MODEL // 4
RNN_BLOCKS = 8
RNN_BLK = D_RNN // RNN_BLOCKS
RNN_K = 4
LRU_C = 8.0
D_FF = 3 * D_MODEL
FFN_K = 3
N_MOD = 6
EPS = 1e-6
IN_SPLITS = [D_CONF, 2 * D_CONF, 2 * D_CONF + D_RNN, 2 * D_CONF + 2 * D_RNN, 2 * D_CONF + 2 * D_RNN + D_MODEL]
D_IN = 2 * D_CONF + 2 * D_RNN + 2 * D_MODEL

kernel_name = "gated_parallel_conformer_rglru_convffn_step"


def _rmsnorm(x, g):
    xf = x.astype(jnp.float32)
    y = xf * lax.rsqrt(jnp.mean(xf * xf, axis=-1, keepdims=True) + EPS) * g.astype(jnp.float32)
    return y.astype(x.dtype)


def _layernorm(x, g, b):
    xf = x.astype(jnp.float32)
    mu = jnp.mean(xf, axis=-1, keepdims=True)
    var = jnp.mean(jnp.square(xf - mu), axis=-1, keepdims=True)
    y = (xf - mu) * lax.rsqrt(var + EPS) * g.astype(jnp.float32) + b.astype(jnp.float32)
    return y.astype(x.dtype)


def _causal_dwconv(buf, u, w, b):
    k = w.shape[0]
    t = u.shape[1]
    full = jnp.concatenate([buf.astype(u.dtype), u], axis=1)
    out = full[:, 0:t] * w[0]
    for j in range(1, k):
        out = out + full[:, j:j + t] * w[j]
    return out + b, full[:, t:]


def _linear_scan(a, bx, h0):
    def step(h, ab):
        a_t, b_t = ab
        h = a_t * h + b_t
        return h, h
    h_last, hs = lax.scan(step, h0, (jnp.swapaxes(a, 0, 1), jnp.swapaxes(bx, 0, 1)))
    return jnp.swapaxes(hs, 0, 1), h_last


def _layer(x, c, conf_buf, rconv_buf, h0, ffn_buf, p):
    bsz, t, _ = x.shape
    mod = jax.nn.silu(c) @ p["w_ada"] + p["b_ada"]
    shift1, scale1, gate1, shift2, scale2, gate2 = [m[:, None, :] for m in jnp.split(mod, N_MOD, axis=-1)]

    h = _rmsnorm(x, p["g_norm1"]) * (1 + scale1) + shift1
    z = h @ p["w_in"]
    conf_v, conf_g, rnn_x, rnn_gate, mg_a, mg_b = jnp.split(z, IN_SPLITS, axis=-1)

    u = conf_v * jax.nn.sigmoid(conf_g)
    u, new_conf_buf = _causal_dwconv(conf_buf, u, p["w_conf_dw"], p["b_conf_dw"])
    u = jax.nn.silu(_layernorm(u, p["g_conf_ln"], p["b_conf_ln"]))
    y_a = u @ p["w_conf_out"]

    xr, new_rconv_buf = _causal_dwconv(rconv_buf, rnn_x, p["w_rnn_conv"], p["b_rnn_conv"])
    xb = xr.reshape(bsz, t, RNN_BLOCKS, RNN_BLK)
    r = jax.nn.sigmoid((jnp.einsum("btgi,gij->btgj", xb, p["w_rg"]).reshape(bsz, t, D_RNN) + p["b_rg"]).astype(jnp.float32))
    ig = jax.nn.sigmoid((jnp.einsum("btgi,gij->btgj", xb, p["w_ig"]).reshape(bsz, t, D_RNN) + p["b_ig"]).astype(jnp.float32))
    log_a = -LRU_C * r * jax.nn.softplus(-p["lru_lambda"].astype(jnp.float32))
    a = jnp.exp(log_a)
    mult = jnp.sqrt(-jnp.expm1(2.0 * log_a))
    bx = mult * ig * xr.astype(jnp.float32)
    hs, h_last = _linear_scan(a, bx, h0.astype(jnp.float32))
    y_b = (hs.astype(x.dtype) * jax.nn.gelu(rnn_gate)) @ p["w_rnn_out"]

    merged = jax.nn.sigmoid(mg_a) * y_a + jax.nn.sigmoid(mg_b) * y_b
    x = x + gate1 * (merged @ p["w_out"])

    h = _rmsnorm(x, p["g_norm2"]) * (1 + scale2) + shift2
    up = h @ p["w_up"]
    up, new_ffn_buf = _causal_dwconv(ffn_buf, up, p["w_ffn_dw"], p["b_ffn_dw"])
    g, v = jnp.split(up, 2, axis=-1)
    x = x + gate2 * ((jax.nn.gelu(g) * v) @ p["w_down"])
    return x, new_conf_buf, new_rconv_buf, h_last.astype(x.dtype), new_ffn_buf


def setup_inputs(seed: int = 0) -> dict:
    key = jax.random.key(seed)
    ks = jax.random.split(key, 40)
    f32 = jnp.float32
    nrm = lambda k, shape, scale: jax.random.normal(k, shape, f32) * scale
    L = DEPTH
    u_a = jax.random.uniform(ks[0], (L, D_RNN), f32, 0.9, 0.999)
    s = u_a ** (1.0 / LRU_C)
    lru_lambda = jnp.log(s / (1.0 - s))
    return {
        "x_prompt": nrm(ks[1], (BATCH, SEQ, D_MODEL), 1.0),
        "x_sample": nrm(ks[2], (DEC_BATCH, DEC_SEQ, D_MODEL), 1.0),
        "state_conf_conv": nrm(ks[3], (L, DEC_BATCH, CONF_K - 1, D_CONF), 0.5),
        "state_rnn_conv": nrm(ks[4], (L, DEC_BATCH, RNN_K - 1, D_RNN), 0.5),
        "state_rnn_h": nrm(ks[5], (L, DEC_BATCH, D_RNN), 0.5),
        "state_ffn_conv": nrm(ks[6], (L, DEC_BATCH, FFN_K - 1, 2 * D_FF), 0.5),
        "c_prompt": nrm(ks[7], (BATCH, D_MODEL), 1.0),
        "c_sample": nrm(ks[8], (DEC_BATCH, D_MODEL), 1.0),
        "w_ada": nrm(ks[9], (L, D_MODEL, N_MOD * D_MODEL), 0.5 * D_MODEL ** -0.5),
        "b_ada": nrm(ks[10], (L, N_MOD * D_MODEL), 0.02),
        "g_norm1": 1.0 + nrm(ks[11], (L, D_MODEL), 0.02),
        "w_in": nrm(ks[12], (L, D_MODEL, D_IN), D_MODEL ** -0.5),
        "w_conf_dw": nrm(ks[13], (L, CONF_K, D_CONF), CONF_K ** -0.5),
        "b_conf_dw": nrm(ks[14], (L, D_CONF), 0.02),
        "g_conf_ln": 1.0 + nrm(ks[15], (L, D_CONF), 0.02),
        "b_conf_ln": nrm(ks[16], (L, D_CONF), 0.02),
        "w_conf_out": nrm(ks[17], (L, D_CONF, D_MODEL), D_CONF ** -0.5),
        "w_rnn_conv": nrm(ks[18], (L, RNN_K, D_RNN), RNN_K ** -0.5),
        "b_rnn_conv": nrm(ks[19], (L, D_RNN), 0.02),
        "w_rg": nrm(ks[20], (L, RNN_BLOCKS, RNN_BLK, RNN_BLK), RNN_BLK ** -0.5),
        "b_rg": nrm(ks[21], (L, D_RNN), 0.02),
        "w_ig": nrm(ks[22], (L, RNN_BLOCKS, RNN_BLK, RNN_BLK), RNN_BLK ** -0.5),
        "b_ig": nrm(ks[23], (L, D_RNN), 0.02),
        "lru_lambda": lru_lambda,
        "w_rnn_out": nrm(ks[24], (L, D_RNN, D_MODEL), D_RNN ** -0.5),
        "w_out": nrm(ks[25], (L, D_MODEL, D_MODEL), D_MODEL ** -0.5),
        "g_norm2": 1.0 + nrm(ks[26], (L, D_MODEL), 0.02),
        "w_up": nrm(ks[27], (L, D_MODEL, 2 * D_FF), D_MODEL ** -0.5),
        "w_ffn_dw": nrm(ks[28], (L, FFN_K, 2 * D_FF), FFN_K ** -0.5),
        "b_ffn_dw": nrm(ks[29], (L, 2 * D_FF), 0.02),
        "w_down": nrm(ks[30], (L, D_FF, D_MODEL), D_FF ** -0.5),
        "g_final": 1.0 + nrm(ks[31], (D_MODEL,), 0.02),
    }


def reference(x_prompt, x_sample, state_conf_conv, state_rnn_conv, state_rnn_h, state_ffn_conv,
              c_prompt, c_sample, w_ada, b_ada, g_norm1, w_in, w_conf_dw, b_conf_dw, g_conf_ln,
              b_conf_ln, w_conf_out, w_rnn_conv, b_rnn_conv, w_rg, b_rg, w_ig, b_ig, lru_lambda,
              w_rnn_out, w_out, g_norm2, w_up, w_ffn_dw, b_ffn_dw, w_down, g_final):
    bp = x_prompt.shape[0]
    dt = x_prompt.dtype
    xp, xs = x_prompt, x_sample
    conf_p, rconv_p, h_p, ffn_p = [], [], [], []
    conf_s, rconv_s, h_s, ffn_s = [], [], [], []
    for l in range(DEPTH):
        p = {"w_ada": w_ada[l], "b_ada": b_ada[l], "g_norm1": g_norm1[l], "w_in": w_in[l],
             "w_conf_dw": w_conf_dw[l], "b_conf_dw": b_conf_dw[l], "g_conf_ln": g_conf_ln[l],
             "b_conf_ln": b_conf_ln[l], "w_conf_out": w_conf_out[l], "w_rnn_conv": w_rnn_conv[l],
             "b_rnn_conv": b_rnn_conv[l], "w_rg": w_rg[l], "b_rg": b_rg[l], "w_ig": w_ig[l],
             "b_ig": b_ig[l], "lru_lambda": lru_lambda[l], "w_rnn_out": w_rnn_out[l],
             "w_out": w_out[l], "g_norm2": g_norm2[l], "w_up": w_up[l], "w_ffn_dw": w_ffn_dw[l],
             "b_ffn_dw": b_ffn_dw[l], "w_down": w_down[l]}
        xp, cb, rb, hl, fb = _layer(
            xp, c_prompt,
            jnp.zeros((bp, CONF_K - 1, D_CONF), dt), jnp.zeros((bp, RNN_K - 1, D_RNN), dt),
            jnp.zeros((bp, D_RNN), dt), jnp.zeros((bp, FFN_K - 1, 2 * D_FF), dt), p)
        conf_p.append(cb); rconv_p.append(rb); h_p.append(hl); ffn_p.append(fb)
        xs, cb, rb, hl, fb = _layer(
            xs, c_sample, state_conf_conv[l], state_rnn_conv[l], state_rnn_h[l], state_ffn_conv[l], p)
        conf_s.append(cb); rconv_s.append(rb); h_s.append(hl); ffn_s.append(fb)
    y_prompt = _rmsnorm(xp, g_final)
    y_sample = _rmsnorm(xs, g_final)
    return (y_prompt, y_sample,
            jnp.stack(conf_p), jnp.stack(rconv_p), jnp.stack(h_p), jnp.stack(ffn_p),
            jnp.stack(conf_s), jnp.stack(rconv_s), jnp.stack(h_s), jnp.stack(ffn_s))
```

```cpp
#include <hip/hip_runtime.h>
#include <hip/hip_cooperative_groups.h>
#include <cstdio>
namespace cg = cooperative_groups;

#define LAS __attribute__((address_space(3)))
typedef unsigned short bf16_t;
typedef short bf16x8 __attribute__((ext_vector_type(8)));
typedef float f32x4 __attribute__((ext_vector_type(4)));
typedef float f32x2 __attribute__((ext_vector_type(2)));
typedef unsigned u32x4 __attribute__((ext_vector_type(4)));
typedef unsigned u32x2 __attribute__((ext_vector_type(2)));

constexpr int MP = 16384, MS = 1024, MT = MP + MS;
constexpr int DM = 1024, DC = 1024, DR = 1280, DFF = 3072, DIN = 6656, NMOD = 6144, NBATCH = 136;
constexpr int SEQ = 2048, DSEQ = 8;
constexpr float EPS = 1e-6f;
constexpr int NTHREADS = 512, NWAVES = 8;
#ifndef REP_PHASE
#define REP_PHASE -1
#endif
#define REPS(k) ((REP_PHASE == (k)) ? 2 : 1)

constexpr size_t A1K = (size_t)MT * 1024 * 2, A1280 = (size_t)MT * 1280 * 2;
constexpr size_t WS_WIN = 0;
constexpr size_t WS_WCA = WS_WIN + (size_t)DIN * 1024 * 2;
constexpr size_t WS_WRB = WS_WCA + (size_t)1024 * 1024 * 2;
constexpr size_t WS_WO  = WS_WRB + (size_t)1024 * 1280 * 2;
constexpr size_t WS_WUP = WS_WO + (size_t)1024 * 1024 * 2;
constexpr size_t WS_WDN = WS_WUP + (size_t)6144 * 1024 * 2;
constexpr size_t WS_WRG = WS_WDN + (size_t)1024 * 3072 * 2;
constexpr size_t WS_WIG = WS_WRG + (size_t)8 * 160 * 160 * 2;
constexpr size_t WS_MOD = WS_WIG + (size_t)8 * 160 * 160 * 2;
constexpr size_t WS_HL  = WS_MOD + (size_t)NBATCH * NMOD * 4;
constexpr size_t WS_PL  = WS_HL + (size_t)8 * 32 * 1280 * 4;
constexpr size_t WS_SP8 = WS_PL + (size_t)8 * 32 * 1280 * 4;
constexpr size_t WS_BAR = ((WS_SP8 + (size_t)1280 * 4 + 255) / 256) * 256;
constexpr size_t WS_BAR_BYTES = 3456 * 4;
constexpr size_t WS_SCH = ((WS_BAR + WS_BAR_BYTES + 255) / 256) * 256;
constexpr size_t WS_SCL = WS_SCH + (size_t)144 * 1024 * 2;
constexpr size_t WS_S0  = ((WS_SCL + (size_t)144 * 1024 * 2 + 4095) / 4096) * 4096;
constexpr size_t WS_S3  = WS_S0 + A1K;
constexpr size_t WS_S1  = WS_S3 + A1280;
constexpr size_t WS_S2  = WS_S1 + A1K;
constexpr size_t WS_S4  = WS_S2 + A1280;
constexpr size_t WS_ACT = WS_S1;
constexpr size_t WS_UPA = WS_ACT + (size_t)MT * 3072 * 2;
constexpr size_t WS_UPB = WS_UPA + (size_t)68 * 2 * 6144 * 4;
constexpr size_t WS_END0 = WS_S4 + A1280;
constexpr size_t WS_END1 = WS_UPB + (size_t)68 * 2 * 6144 * 4;
static_assert(WS_END1 <= WS_END0, "act + side buffers must fit in S1..S4");
constexpr size_t WS_UPS = WS_S3;
static_assert((size_t)MS * 6144 * 4 <= A1280, "ups fits S3");
constexpr size_t WS_NEED = WS_END0;
static_assert(WS_NEED <= (size_t)256 * 1024 * 1024, "workspace budget");

constexpr size_t O_Y = 0;
constexpr size_t O_CONF_P = (size_t)MT * 1024;
constexpr size_t O_RCONV_P = O_CONF_P + (size_t)8 * 30 * 1024;
constexpr size_t O_H_P = O_RCONV_P + (size_t)8 * 3 * 1280;
constexpr size_t O_FFN_P = O_H_P + (size_t)8 * 1280;
constexpr size_t O_CONF_S = O_FFN_P + (size_t)8 * 2 * 6144;
constexpr size_t O_RCONV_S = O_CONF_S + (size_t)128 * 30 * 1024;
constexpr size_t O_H_S = O_RCONV_S + (size_t)128 * 3 * 1280;
constexpr size_t O_FFN_S = O_H_S + (size_t)128 * 1280;
constexpr size_t O_END = O_FFN_S + (size_t)128 * 2 * 6144;

constexpr int LDS_STAGE = 131072, LDS_EXCH = 8192, LDS_CW = LDS_STAGE + LDS_EXCH, LDS_BARW = LDS_CW + 4096, LDS_BYTES = LDS_BARW + 16;

struct Params { const float* in[32]; float* out; unsigned char* ws; };

typedef __bf16 bf16x2_t __attribute__((ext_vector_type(2)));
__device__ __forceinline__ unsigned pk_bf16(float lo, float hi) { const f32x2 v = {lo, hi}; const bf16x2_t b = __builtin_convertvector(v, bf16x2_t); return __builtin_bit_cast(unsigned, b); }
__device__ __forceinline__ float bf_lo(unsigned w) { return __uint_as_float(w << 16); }
__device__ __forceinline__ float bf_hi(unsigned w) { return __uint_as_float(w & 0xffff0000u); }
__device__ __forceinline__ float sigmoidf_(float x) { return __builtin_amdgcn_rcpf(1.0f + __expf(-x)); }
__device__ __forceinline__ float siluf_(float x) { return x * sigmoidf_(x); }
__device__ __forceinline__ float gelu_tanh(float x) { const float u = 1.5957691216057308f * (x + 0.044715f * x * x * x); return x * sigmoidf_(u); }
__device__ __forceinline__ f32x2 sigmoid2(f32x2 x) { const f32x2 t = x * (-1.4426950408889634f); f32x2 e; e.x = __builtin_amdgcn_exp2f(t.x); e.y = __builtin_amdgcn_exp2f(t.y);
    const f32x2 d = e + 1.0f; f32x2 r; r.x = __builtin_amdgcn_rcpf(d.x); r.y = __builtin_amdgcn_rcpf(d.y); return r; }
__device__ __forceinline__ f32x2 gelu2(f32x2 x) {
    const f32x2 t = x * ((x * x) * (-0.10294324f) + (-2.3022082f)); f32x2 e; e.x = __builtin_amdgcn_exp2f(t.x); e.y = __builtin_amdgcn_exp2f(t.y);
    const f32x2 d = e + 1.0f; f32x2 r; r.x = __builtin_amdgcn_rcpf(d.x); r.y = __builtin_amdgcn_rcpf(d.y); return x * r; }
__device__ __forceinline__ float wave_sum(float v) {
#pragma unroll
    for (int o = 1; o < 64; o <<= 1) v += __shfl_xor(v, o);
    return v;
}
__device__ __forceinline__ int batch_of_row(int r) { return r < MP ? (r >> 11) : 8 + ((r - MP) >> 3); }
__device__ __forceinline__ int opaque_tid() { int t = threadIdx.x; asm volatile("" : "+v"(t)); return t; }
#define LDS_FENCE() asm volatile("s_waitcnt lgkmcnt(0)" ::: "memory")

namespace pg8 {
constexpr int BM = 256, BK = 64, HALF = 128, HTB = HALF * BK * 2, STAGE_BYTES = 8 * HTB, NXCD = 8, WGM = 8;
__host__ __device__ __forceinline__ int lds_byte(int r, int c) { const int st = (r >> 4) * 2 + (c >> 5), rr = r & 15, cc = c & 31, ob = rr * 64 + cc * 2; return st * 1024 + (ob ^ (((ob >> 9) & 1) << 5)); }
__host__ __device__ __forceinline__ void stage_rc(int b, int& R, int& C) { const int st = b / 1024, sb = b % 1024, swz = sb ^ (((sb >> 9) & 1) << 5); R = (st >> 1) * 16 + swz / 64; C = (st & 1) * 32 + (swz % 64) / 2; }
__host__ __device__ __forceinline__ int perm32(int rho) { const int n = rho >> 4, i = rho & 15; return 8 * (i >> 2) + 4 * n + (i & 3); }
struct Unit { int pm, pn; };
struct Gemm { const bf16_t* A; const bf16_t* Bt; int M, N, K; };
struct StaticOrder {
    int nM, nN, nwg, G, c;
    __device__ void init(int M, int N, int G_, int c_) { nM = M / BM; nN = N / BM; nwg = nM * nN; G = G_; c = c_; }
    __device__ bool next(int i, Unit& u) const {
        const long L = (long)i * G + c; if (L >= nwg) return false;
        int wgid = (int)L; { const int q = nwg / NXCD, r = nwg % NXCD, xcd = wgid % NXCD, off = wgid / NXCD; wgid = (xcd < r ? xcd * (q + 1) : r * (q + 1) + (xcd - r) * q) + off; }
        const int nig = WGM * nN, gid = wgid / nig, fm = gid * WGM, gsz = (nM - fm) < WGM ? (nM - fm) : WGM;
        u.pm = fm + ((wgid % nig) % gsz); u.pn = (wgid % nig) / gsz; return true;
    }
};

template <class Epi>
__device__ __forceinline__ void gemm_phase(LAS unsigned char* lds, const Gemm g, const StaticOrder& S, const Epi& E) {
    int tid_ = threadIdx.x; asm volatile("" : "+v"(tid_));
    const int tid = tid_, wid = __builtin_amdgcn_readfirstlane(tid >> 6), lane = tid & 63, wr = wid >> 2, wc = wid & 3, fr = lane & 15, fq = lane >> 4;
    const int K = g.K, nt = K / BK;
    unsigned voffA[2], voffB[2];
#pragma unroll
    for (int i = 0; i < 2; ++i) { int R, C; stage_rc(tid * 16 + i * 8192, R, C); const int Rb = Epi::PERM ? ((R & ~31) + perm32(R & 31)) : R;
        voffA[i] = (unsigned)(R * K + C) * 2u; voffB[i] = (unsigned)(Rb * K + C) * 2u; }
    const size_t kstep = (size_t)(BK * 2);
    const size_t hstep = (size_t)HALF * K * 2;
    const size_t tstep = 2 * hstep;
    const unsigned ldsw = (unsigned)wid * 1024u;
    const int aoff = lds_byte(wr * 64 + fr, fq * 8), boff = lds_byte(wc * 32 + fr, fq * 8);
#define PG8_SA(b, h) (((b) * 2 + (h)) * HTB)
#define PG8_SB(b, h) ((4 + (b) * 2 + (h)) * HTB)
#define PG8_STAGE(bufoff, gbase, voff) do { _Pragma("unroll") for (int _i = 0; _i < 2; ++_i) \
        __builtin_amdgcn_global_load_lds((const unsigned*)((const char*)(gbase) + (voff)[_i]), (LAS unsigned*)(lds + (bufoff) + ldsw + _i * 8192), 16, 0, 0); } while (0)
#define PG8_LDA(dst, b, h) do { _Pragma("unroll") for (int m = 0; m < 4; ++m) _Pragma("unroll") for (int k = 0; k < 2; ++k) dst[m][k] = *(const LAS bf16x8*)(lds + PG8_SA(b, h) + aoff + m * 2048 + k * 1024); } while (0)
#define PG8_LDB(dst, b, h) do { _Pragma("unroll") for (int n = 0; n < 2; ++n) _Pragma("unroll") for (int k = 0; k < 2; ++k) dst[n][k] = *(const LAS bf16x8*)(lds + PG8_SB(b, h) + boff + n * 2048 + k * 1024); } while (0)
#define PG8_MMA(ai, bj, At, Bt) do { __builtin_amdgcn_s_setprio(1); _Pragma("unroll") for (int m = 0; m < 4; ++m) _Pragma("unroll") for (int n = 0; n < 2; ++n) _Pragma("unroll") for (int k = 0; k < 2; ++k) \
        acc[ai][bj][m][n] = __builtin_amdgcn_mfma_f32_16x16x32_bf16(Bt[n][k], At[m][k], acc[ai][bj][m][n], 0, 0, 0); __builtin_amdgcn_s_setprio(0); } while (0)
#define PG8_WAIT_V(n) asm volatile("s_waitcnt vmcnt(" #n ")" ::: "memory")
#define PG8_WAIT_L(n) asm volatile("s_waitcnt lgkmcnt(" #n ")" ::: "memory")
#define PG8_BAR __builtin_amdgcn_s_barrier()
#define PG8_SCHED __builtin_amdgcn_sched_barrier(0)
    Unit cur, nxt; int ui = 0;
    if (!S.next(0, cur)) return;
    f32x4 acc[2][2][4][2];
#pragma unroll
    for (int a = 0; a < 2; ++a)
#pragma unroll
        for (int b = 0; b < 2; ++b)
#pragma unroll
            for (int m = 0; m < 4; ++m)
#pragma unroll
                for (int n = 0; n < 2; ++n) acc[a][b][m][n] = (f32x4){0.f, 0.f, 0.f, 0.f};
    bf16x8 At[4][2], B0[2][2], B1[2][2];
    const char* cA = (const char*)g.A + (size_t)cur.pm * tstep; const char* cB = (const char*)g.Bt + (size_t)cur.pn * tstep;
    PG8_STAGE(PG8_SB(0, 0), cB, voffB); PG8_STAGE(PG8_SA(0, 0), cA, voffA); PG8_STAGE(PG8_SB(0, 1), cB + hstep, voffB); PG8_STAGE(PG8_SA(0, 1), cA + hstep, voffA);
    if (wr == 1) PG8_BAR;
    PG8_WAIT_V(4); PG8_BAR;
    PG8_STAGE(PG8_SB(1, 0), cB + kstep, voffB); PG8_STAGE(PG8_SA(1, 0), cA + kstep, voffA); PG8_STAGE(PG8_SB(1, 1), cB + hstep + kstep, voffB);
    PG8_WAIT_V(6); PG8_BAR;
    for (;;) {
        const bool has_next = S.next(ui + 1, nxt);
        const char* nA = has_next ? (const char*)g.A + (size_t)nxt.pm * tstep : cA; const char* nB = has_next ? (const char*)g.Bt + (size_t)nxt.pn * tstep : cB;
        for (int t = 0; t < nt; t += 2) {
            const bool last = (t == nt - 2);
            const char* a1 = cA + (size_t)(t + 1) * kstep;
            const char* a2 = last ? nA : cA + (size_t)(t + 2) * kstep; const char* b2 = last ? nB : cB + (size_t)(t + 2) * kstep;
            const char* a3 = a2 + kstep; const char* b3 = b2 + kstep;
            PG8_LDB(B0, 0, 0); PG8_SCHED; PG8_LDA(At, 0, 0); PG8_STAGE(PG8_SA(1, 1), a1 + hstep, voffA);
            PG8_WAIT_L(8); PG8_BAR; PG8_WAIT_L(0); PG8_MMA(0, 0, At, B0); PG8_BAR; PG8_SCHED;
            PG8_LDB(B1, 0, 1); PG8_STAGE(PG8_SB(0, 0), b2, voffB);
            PG8_BAR; PG8_WAIT_L(0); PG8_MMA(0, 1, At, B1); PG8_BAR;
            PG8_LDA(At, 0, 1); PG8_STAGE(PG8_SA(0, 0), a2, voffA);
            PG8_BAR; PG8_WAIT_L(0); PG8_MMA(1, 0, At, B0); PG8_BAR; PG8_SCHED;
            PG8_STAGE(PG8_SB(0, 1), b2 + hstep, voffB);
            PG8_WAIT_V(6); PG8_BAR; PG8_MMA(1, 1, At, B1); PG8_BAR;
            PG8_LDB(B0, 1, 0); PG8_SCHED; PG8_LDA(At, 1, 0); PG8_STAGE(PG8_SA(0, 1), a2 + hstep, voffA);
            PG8_WAIT_L(8); PG8_BAR; PG8_WAIT_L(0); PG8_MMA(0, 0, At, B0); PG8_BAR; PG8_SCHED;
            PG8_LDB(B1, 1, 1); PG8_STAGE(PG8_SB(1, 0), b3, voffB);
            PG8_BAR; PG8_WAIT_L(0); PG8_MMA(0, 1, At, B1); PG8_BAR;
            PG8_LDA(At, 1, 1); PG8_STAGE(PG8_SA(1, 0), a3, voffA);
            PG8_BAR; PG8_WAIT_L(0); PG8_MMA(1, 0, At, B0); PG8_BAR; PG8_SCHED;
            PG8_STAGE(PG8_SB(1, 1), b3 + hstep, voffB);
            PG8_WAIT_V(6); PG8_BAR; PG8_MMA(1, 1, At, B1); PG8_BAR;
        }
        { int e_fr = fr, e_fq = fq, e_wr = wr, e_wc = wc; asm volatile("" : "+v"(e_fr), "+v"(e_fq), "+s"(e_wr), "+s"(e_wc));
          E(acc, cur, e_wr, e_wc, e_fr, e_fq); }
        if (!has_next) break;
#pragma unroll
        for (int a = 0; a < 2; ++a)
#pragma unroll
            for (int b = 0; b < 2; ++b)
#pragma unroll
                for (int m = 0; m < 4; ++m)
#pragma unroll
                    for (int n = 0; n < 2; ++n) acc[a][b][m][n] = (f32x4){0.f, 0.f, 0.f, 0.f};
        cur = nxt; cA = nA; cB = nB; ++ui;
    }
    PG8_WAIT_V(0);
    if (wr == 0) PG8_BAR;
    PG8_BAR;
#undef PG8_SA
#undef PG8_SB
#undef PG8_STAGE
#undef PG8_LDA
#undef PG8_LDB
#undef PG8_MMA
#undef PG8_WAIT_V
#undef PG8_WAIT_L
#undef PG8_SCHED
}
}
using pg8::Unit;

typedef const f32x4 (&AccRef)[2][2][4][2];

struct EpiIn {
    static constexpr bool PERM = true;
    bf16_t *uglu, *rnnx, *gg, *sga, *sgb; float* out;
    __device__ __forceinline__ void operator()(AccRef acc, const Unit& u, int wr, int wc, int fr, int fq) const {
        const int row0 = u.pm * 256 + wr * 64 + fr, cl = wc * 32 + 8 * fq;
        if (u.pn < 8) {
            const int col = u.pn * 128 + cl;
#pragma unroll
            for (int ai = 0; ai < 2; ++ai)
#pragma unroll
                for (int m = 0; m < 4; ++m) {
                    const int r = row0 + ai * 128 + m * 16;
                    f32x4 o[2];
#pragma unroll
                    for (int n = 0; n < 2; ++n)
#pragma unroll
                        for (int jp = 0; jp < 2; ++jp) { const f32x2 vv = {acc[ai][0][m][n][2 * jp], acc[ai][0][m][n][2 * jp + 1]}, gg2 = {acc[ai][1][m][n][2 * jp], acc[ai][1][m][n][2 * jp + 1]};
                            const f32x2 r = vv * sigmoid2(gg2); o[n][2 * jp] = r.x; o[n][2 * jp + 1] = r.y; }
                    u32x4 w; w.x = pk_bf16(o[0][0], o[0][1]); w.y = pk_bf16(o[0][2], o[0][3]); w.z = pk_bf16(o[1][0], o[1][1]); w.w = pk_bf16(o[1][2], o[1][3]);
                    *(u32x4*)(uglu + (size_t)r * 1024 + col) = w;
                    float* so = nullptr;
                    if (r < MP) { const int t = r & 2047; if (t >= 2018) so = out + O_CONF_P + ((size_t)(r >> 11) * 30 + (t - 2018)) * 1024 + col; }
                    else { const int s = r - MP; so = out + O_CONF_S + ((size_t)(s >> 3) * 30 + 22 + (s & 7)) * 1024 + col; }
                    if (so) { *(f32x4*)so = o[0]; *(f32x4*)(so + 4) = o[1]; }
                }
        } else if (u.pn < 13) {
#pragma unroll
            for (int ai = 0; ai < 2; ++ai)
#pragma unroll
                for (int m = 0; m < 4; ++m) {
                    const int r = row0 + ai * 128 + m * 16;
                    float* so = nullptr;
                    if (r < MP) { const int t = r & 2047; if (t >= 2045) so = out + O_RCONV_P + ((size_t)(r >> 11) * 3 + (t - 2045)) * 1280; }
                    else { const int s = r - MP; if ((s & 7) >= 5) so = out + O_RCONV_S + ((size_t)(s >> 3) * 3 + (s & 7) - 5) * 1280; }
#pragma unroll
                    for (int bj = 0; bj < 2; ++bj) {
                        const int col = (u.pn - 8) * 256 + bj * 128 + cl;
                        const f32x4 v0 = acc[ai][bj][m][0], v1 = acc[ai][bj][m][1];
                        u32x4 w; w.x = pk_bf16(v0[0], v0[1]); w.y = pk_bf16(v0[2], v0[3]); w.z = pk_bf16(v1[0], v1[1]); w.w = pk_bf16(v1[2], v1[3]);
                        *(u32x4*)(rnnx + (size_t)r * 1280 + col) = w;
                        if (so) { *(f32x4*)(so + col) = v0; *(f32x4*)(so + col + 4) = v1; }
                    }
                }
        } else if (u.pn < 18) { act_store<true>(acc, gg, 1280, (u.pn - 13) * 256 + cl, row0); }
        else if (u.pn < 22) { act_store<false>(acc, sga, 1024, (u.pn - 18) * 256 + cl, row0); }
        else { act_store<false>(acc, sgb, 1024, (u.pn - 22) * 256 + cl, row0); }
    }
    template <bool ISG> __device__ __forceinline__ void act_store(AccRef acc, bf16_t* dst, int ld, int c0, int row0) const {
#pragma unroll
        for (int ai = 0; ai < 2; ++ai)
#pragma unroll
            for (int m = 0; m < 4; ++m) {
                const int r = row0 + ai * 128 + m * 16;
#pragma unroll
                for (int bj = 0; bj < 2; ++bj) {
                    f32x4 v0 = acc[ai][bj][m][0], v1 = acc[ai][bj][m][1];
#pragma unroll
                    for (int jp = 0; jp < 2; ++jp) { const f32x2 a = {v0[2 * jp], v0[2 * jp + 1]}, b = {v1[2 * jp], v1[2 * jp + 1]};
                        const f32x2 ra = ISG ? gelu2(a) : sigmoid2(a), rb = ISG ? gelu2(b) : sigmoid2(b);
                        v0[2 * jp] = ra.x; v0[2 * jp + 1] = ra.y; v1[2 * jp] = rb.x; v1[2 * jp + 1] = rb.y; }
                    u32x4 w; w.x = pk_bf16(v0[0], v0[1]); w.y = pk_bf16(v0[2], v0[3]); w.z = pk_bf16(v1[0], v1[1]); w.w = pk_bf16(v1[2], v1[3]);
                    *(u32x4*)(dst + (size_t)r * ld + c0 + bj * 128) = w;
                }
            }
    }
};

template <int MODE> struct EpiMerge {
    static constexpr bool PERM = true;
    bf16_t* T; const bf16_t* gate;
    __device__ __forceinline__ void operator()(AccRef acc, const Unit& u, int wr, int wc, int fr, int fq) const {
        const int row0 = u.pm * 256 + wr * 64 + fr, col0 = u.pn * 256 + wc * 32 + 8 * fq;
#pragma unroll
        for (int ai = 0; ai < 2; ++ai)
#pragma unroll
            for (int m = 0; m < 4; ++m) {
                const size_t rb = (size_t)(row0 + ai * 128 + m * 16) * 1024;
#pragma unroll
                for (int bj = 0; bj < 2; ++bj) {
                    const size_t off = rb + col0 + bj * 128;
                    const u32x4 gw = *(const u32x4*)(gate + off);
                    const f32x4 v0 = acc[ai][bj][m][0], v1 = acc[ai][bj][m][1];
                    float o[8];
                    o[0] = v0[0] * bf_lo(gw.x); o[1] = v0[1] * bf_hi(gw.x); o[2] = v0[2] * bf_lo(gw.y); o[3] = v0[3] * bf_hi(gw.y);
                    o[4] = v1[0] * bf_lo(gw.z); o[5] = v1[1] * bf_hi(gw.z); o[6] = v1[2] * bf_lo(gw.w); o[7] = v1[3] * bf_hi(gw.w);
                    if (MODE == 1) { const u32x4 tw = *(const u32x4*)(T + off);
                        o[0] += bf_lo(tw.x); o[1] += bf_hi(tw.x); o[2] += bf_lo(tw.y); o[3] += bf_hi(tw.y); o[4] += bf_lo(tw.z); o[5] += bf_hi(tw.z); o[6] += bf_lo(tw.w); o[7] += bf_hi(tw.w); }
                    u32x4 w; w.x = pk_bf16(o[0], o[1]); w.y = pk_bf16(o[2], o[3]); w.z = pk_bf16(o[4], o[5]); w.w = pk_bf16(o[6], o[7]);
                    *(u32x4*)(T + off) = w;
                }
            }
    }
};

template <bool INPLACE> struct EpiRes {
    static constexpr bool PERM = true;
    const float* xp; bf16_t* xb; const float* mod; int goff;
    __device__ __forceinline__ void operator()(AccRef acc, const Unit& u, int wr, int wc, int fr, int fq) const {
        const int row0 = u.pm * 256 + wr * 64 + fr, col0 = u.pn * 256 + wc * 32 + 8 * fq;
#pragma unroll
        for (int ai = 0; ai < 2; ++ai)
#pragma unroll
            for (int m = 0; m < 4; ++m) {
                const int r = row0 + ai * 128 + m * 16;
                const float* gp = mod + (size_t)(r >> 11) * NMOD + goff;
#pragma unroll
                for (int bj = 0; bj < 2; ++bj) {
                    const int c = col0 + bj * 128;
                    const f32x4 g0 = *(const f32x4*)(gp + c), g1 = *(const f32x4*)(gp + c + 4);
                    f32x4 x0, x1;
                    if (!INPLACE) { x0 = *(const f32x4*)(xp + (size_t)r * 1024 + c); x1 = *(const f32x4*)(xp + (size_t)r * 1024 + c + 4); }
                    else { const u32x4 w = *(const u32x4*)(xb + (size_t)r * 1024 + c); x0 = (f32x4){bf_lo(w.x), bf_hi(w.x), bf_lo(w.y), bf_hi(w.y)}; x1 = (f32x4){bf_lo(w.z), bf_hi(w.z), bf_lo(w.w), bf_hi(w.w)}; }
                    x0 = x0 + g0 * acc[ai][bj][m][0]; x1 = x1 + g1 * acc[ai][bj][m][1];
                    u32x4 o; o.x = pk_bf16(x0[0], x0[1]); o.y = pk_bf16(x0[2], x0[3]); o.z = pk_bf16(x1[0], x1[1]); o.w = pk_bf16(x1[2], x1[3]);
                    *(u32x4*)(xb + (size_t)r * 1024 + c) = o;
                }
            }
    }
};

struct EpiUp {
    static constexpr bool PERM = true;
    bf16_t* act; const float* wdw; const float* bdw; float* ups; float* upa; float* upb; float* out; LAS unsigned char* exch;
    template <int CTRL> static __device__ __forceinline__ float dpp_keep(float old, float src) {
        return __builtin_bit_cast(float, __builtin_amdgcn_update_dpp(__builtin_bit_cast(int, old), __builtin_bit_cast(int, src), CTRL, 0xf, 0xf, false)); }
    __device__ __forceinline__ void conv_prompt(AccRef acc, const Unit& u, int wr, int wc, int fr, int fq) const {
        const int cl = wc * 32 + 8 * fq;
#pragma unroll
        for (int ai = 0; ai < 2; ++ai) {
            const int slab = 2 * ai + wr;
            const int rowb = u.pm * 256 + ai * 128 + wr * 64 + fr;
#pragma unroll
            for (int n = 0; n < 2; ++n)
#pragma unroll
            for (int jp = 0; jp < 2; ++jp) {
                float gq[4][2];
                int clx = cl;
#pragma unroll
                for (int bj = 0; bj < 2; ++bj) {
                    asm volatile("" : "+v"(clx));
                    const int col = bj * 3072 + u.pn * 128 + clx + 4 * n + 2 * jp;
                    const LAS float* cwp = (const LAS float*)(exch + LDS_EXCH) + bj * 128 + clx + 4 * n + 2 * jp;
                    const f32x2 W0 = *(const LAS f32x2*)cwp, W1 = *(const LAS f32x2*)(cwp + 256), W2 = *(const LAS f32x2*)(cwp + 512), BB = *(const LAS f32x2*)(cwp + 768);
                    f32x2 X1 = {0.f, 0.f}, X2 = {0.f, 0.f};
                    if (slab > 0) {
                        X1 = *(const LAS f32x2*)(exch + (size_t)(((((slab - 1) * 2 + 1) * 2 + bj) * 128 + clx + 4 * n + 2 * jp) * 4));
                        X2 = *(const LAS f32x2*)(exch + (size_t)(((((slab - 1) * 2 + 0) * 2 + bj) * 128 + clx + 4 * n + 2 * jp) * 4));
                    }
#pragma unroll
                    for (int jj = 0; jj < 2; ++jj) {
#pragma unroll
                        for (int m = 0; m < 4; ++m) {
                            const float cur = acc[ai][bj][m][n][2 * jp + jj];
                            float t1, t2;
                            if (m == 0) { t1 = X1[jj]; t2 = (fr == 0) ? X2[jj] : X1[jj]; }
                            else { const float prv = acc[ai][bj][m > 0 ? m - 1 : 0][n][2 * jp + jj]; t1 = dpp_keep<0x10F>(0.f, prv); t2 = dpp_keep<0x10E>(0.f, prv); }
                            const float p1 = dpp_keep<0x111>(t1, cur);
                            const float p2 = dpp_keep<0x112>(t2, cur);
                            const float cv = W2[jj] * cur + W1[jj] * p1 + W0[jj] * p2 + BB[jj];
                            if (bj == 0) gq[m][jj] = gelu_tanh(cv); else gq[m][jj] *= cv;
                        }
                    }
                    __builtin_amdgcn_sched_barrier(0);
                }
#pragma unroll
                for (int m = 0; m < 4; ++m)
                    *(unsigned*)(act + (size_t)(rowb + 16 * m) * 3072 + u.pn * 128 + clx + 4 * n + 2 * jp) = pk_bf16(gq[m][0], gq[m][1]);
                __builtin_amdgcn_sched_barrier(0);
            }
        }
    }
    __device__ __forceinline__ void operator()(AccRef acc, const Unit& u, int wr, int wc, int fr, int fq) const {
        const int cl = wc * 32 + 8 * fq;
        if (u.pm >= 64) {
#pragma unroll
            for (int ai = 0; ai < 2; ++ai)
#pragma unroll
                for (int m = 0; m < 4; ++m) {
                    float* dst = ups + (size_t)((u.pm - 64) * 256 + ai * 128 + wr * 64 + m * 16 + fr) * 6144 + u.pn * 128 + cl;
#pragma unroll
                    for (int bj = 0; bj < 2; ++bj)
#pragma unroll
                        for (int n = 0; n < 2; ++n) *(f32x4*)(dst + bj * 3072 + 4 * n) = acc[ai][bj][m][n];
                }
            __builtin_amdgcn_s_barrier(); __builtin_amdgcn_s_barrier();
            return;
        }
        f32x2 cwv; LAS f32x2* cwd;
        {
            const int t = (wr * 4 + wc) * 64 + fq * 16 + fr;
            const int k = t >> 7, rem = (t & 127) * 2, bj = rem >> 7, c2 = rem & 127;
            const float* srcp = (k < 3 ? wdw + (size_t)k * 6144 : bdw) + bj * 3072 + u.pn * 128 + c2;
            cwv = *(const f32x2*)srcp; cwd = (LAS f32x2*)((LAS float*)(exch + LDS_EXCH) + k * 256 + bj * 128 + c2);
        }
        if (fr >= 14) {
#pragma unroll
            for (int ai = 0; ai < 2; ++ai)
#pragma unroll
                for (int bj = 0; bj < 2; ++bj)
#pragma unroll
                    for (int n = 0; n < 2; ++n)
                        *(LAS f32x4*)(exch + (size_t)(((((2 * ai + wr) * 2 + (fr - 14)) * 2 + bj) * 128 + cl + 4 * n) * 4)) = acc[ai][bj][3][n];
        }
        if (wr == 0 && fr < 2) {
#pragma unroll
            for (int bj = 0; bj < 2; ++bj)
#pragma unroll
                for (int n = 0; n < 2; ++n) *(f32x4*)(upa + ((size_t)(u.pm * 2 + fr)) * 6144 + bj * 3072 + u.pn * 128 + cl + 4 * n) = acc[0][bj][0][n];
        }
        if (wr == 1 && fr >= 14) {
#pragma unroll
            for (int bj = 0; bj < 2; ++bj)
#pragma unroll
                for (int n = 0; n < 2; ++n) {
                    *(f32x4*)(upb + ((size_t)(u.pm * 2 + fr - 14)) * 6144 + bj * 3072 + u.pn * 128 + cl + 4 * n) = acc[1][bj][3][n];
                    if ((u.pm & 7) == 7) *(f32x4*)(out + O_FFN_P + ((size_t)((u.pm >> 3) * 2 + fr - 14)) * 6144 + bj * 3072 + u.pn * 128 + cl + 4 * n) = acc[1][bj][3][n];
                }
        }
        *cwd = cwv;
        asm volatile("s_waitcnt lgkmcnt(0)" ::: "memory");
        __builtin_amdgcn_s_barrier(); __builtin_amdgcn_s_barrier();
        asm volatile("" ::: "memory");
        conv_prompt(acc, u, wr, wc, fr, fq);
    }
};

__device__ __forceinline__ void transpose_item(const float* W, int K, int N, bf16_t* WT, int k0, int n0, int nd0, LAS float* scr, int lane) {
#pragma unroll 8
    for (int i = 0; i < 32; ++i) { const int kk = 2 * i + (lane >> 5); scr[kk * 33 + (lane & 31)] = W[(size_t)(k0 + kk) * N + n0 + (lane & 31)]; }
    LDS_FENCE();
    const int c = lane & 7;
#pragma unroll
    for (int j = 0; j < 4; ++j) { const int n = (lane >> 3) + 8 * j; const LAS float* s = scr + (8 * c) * 33 + n;
        u32x4 o; o.x = pk_bf16(s[0 * 33], s[1 * 33]); o.y = pk_bf16(s[2 * 33], s[3 * 33]); o.z = pk_bf16(s[4 * 33], s[5 * 33]); o.w = pk_bf16(s[6 * 33], s[7 * 33]);
        *(u32x4*)(WT + (size_t)(nd0 + n) * K + k0 + 8 * c) = o; }
    LDS_FENCE();
}
__device__ __forceinline__ int perm_in(int n) { if (n >= 2048) return n; const int bj = n >> 10, rem = n & 1023; return 256 * (rem >> 7) + 128 * bj + (rem & 127); }
__device__ __forceinline__ int perm_up(int n) { const int bj = n >= 3072 ? 1 : 0, rem = n - bj * 3072; return 256 * (rem >> 7) + 128 * bj + (rem & 127); }

__device__ __forceinline__ void split8(const float (&v)[8], bf16x8& hi, bf16x8& lo) {
    unsigned h[4], l[4];
#pragma unroll
    for (int i = 0; i < 4; ++i) { h[i] = pk_bf16(v[2 * i], v[2 * i + 1]); l[i] = pk_bf16(v[2 * i] - bf_lo(h[i]), v[2 * i + 1] - bf_hi(h[i])); }
    u32x4 H = {h[0], h[1], h[2], h[3]}, L = {l[0], l[1], l[2], l[3]};
    hi = __builtin_bit_cast(bf16x8, H); lo = __builtin_bit_cast(bf16x8, L);
}

constexpr int TI0 = (1024 / 64) * (DIN / 32), TI1 = TI0 + (1024 / 64) * (1024 / 32), TI2 = TI1 + (1280 / 64) * (1024 / 32), TI3 = TI2 + (1024 / 64) * (1024 / 32),
              TI4 = TI3 + (1024 / 64) * (6144 / 32), TI5 = TI4 + (3072 / 64) * (1024 / 32);
__device__ __forceinline__ void weight_transposes(const Params& P, LAS unsigned char* lds, int lo, int hi, int rot) {
    const int tid = opaque_tid(), lane = tid & 63, wave = tid >> 6;
    unsigned char* ws = P.ws;
    LAS float* scr = (LAS float*)(lds + wave * 8448);
    const int G = gridDim.x, gw = ((blockIdx.x + rot) % G) * NWAVES + wave, NGW = G * NWAVES;
    for (int it = lo + gw; it < hi; it += NGW) {
        const float* W; int K, N, loc, pm; bf16_t* WT;
        if (it < TI0) { W = P.in[11]; K = 1024; N = DIN; WT = (bf16_t*)(ws + WS_WIN); loc = it; pm = 1; }
        else if (it < TI1) { W = P.in[16]; K = 1024; N = 1024; WT = (bf16_t*)(ws + WS_WCA); loc = it - TI0; pm = 0; }
        else if (it < TI2) { W = P.in[24]; K = 1280; N = 1024; WT = (bf16_t*)(ws + WS_WRB); loc = it - TI1; pm = 0; }
        else if (it < TI3) { W = P.in[25]; K = 1024; N = 1024; WT = (bf16_t*)(ws + WS_WO); loc = it - TI2; pm = 0; }
        else if (it < TI4) { W = P.in[27]; K = 1024; N = 6144; WT = (bf16_t*)(ws + WS_WUP); loc = it - TI3; pm = 2; }
        else { W = P.in[30]; K = 3072; N = 1024; WT = (bf16_t*)(ws + WS_WDN); loc = it - TI4; pm = 0; }
        const int nblk = N / 32, kb = loc / nblk, nb = loc % nblk, n0 = nb * 32;
        const int nd0 = pm == 1 ? perm_in(n0) : (pm == 2 ? perm_up(n0) : n0);
        transpose_item(W, K, N, WT, kb * 64, n0, nd0, scr, lane);
    }
}

__device__ __forceinline__ void phase0(const Params& P, LAS unsigned char* lds) {
    const int tid = opaque_tid(), lane = tid & 63, wave = tid >> 6, G = gridDim.x, bid = blockIdx.x;
    unsigned char* ws = P.ws;
    weight_transposes(P, lds, 0, TI0, 0);
    {
        const int gt = bid * NTHREADS + tid, NT = G * NTHREADS;
        bf16_t* wrg = (bf16_t*)(ws + WS_WRG); bf16_t* wig = (bf16_t*)(ws + WS_WIG);
        for (int e = gt; e < 8 * 160 * 160; e += NT) { const int g = e / 25600, rem = e % 25600, j = rem / 160, i = rem % 160;
            const size_t src = (size_t)g * 25600 + (size_t)i * 160 + j;
            wrg[e] = (bf16_t)(pk_bf16(P.in[19][src], 0.f) & 0xffffu); wig[e] = (bf16_t)(pk_bf16(P.in[21][src], 0.f) & 0xffffu); }
        for (int e = gt; e < 1280; e += NT) ((float*)(ws + WS_SP8))[e] = 8.0f * log1pf(expf(-P.in[23][e]));
        for (int e = gt; e < 144 * 128; e += NT) { const int row = e >> 7, k8 = (e & 127) * 8;
            float av[8];
#pragma unroll
            for (int i = 0; i < 8; ++i) av[i] = 0.f;
            if (row < NBATCH) { const float* cp = (row < 8) ? P.in[6] + (size_t)row * 1024 : P.in[7] + (size_t)(row - 8) * 1024;
                const f32x4 c0 = *(const f32x4*)(cp + k8), c1 = *(const f32x4*)(cp + k8 + 4);
#pragma unroll
                for (int i = 0; i < 4; ++i) { av[i] = siluf_(c0[i]); av[4 + i] = siluf_(c1[i]); } }
            bf16x8 hi, lo; split8(av, hi, lo);
            *(bf16x8*)((bf16_t*)(ws + WS_SCH) + (size_t)row * 1024 + k8) = hi; *(bf16x8*)((bf16_t*)(ws + WS_SCL) + (size_t)row * 1024 + k8) = lo; }
        const f32x4* st = (const f32x4*)P.in[2]; f32x4* dst = (f32x4*)(P.out + O_CONF_S);
        for (int e = gt; e < 128 * 22 * 256; e += NT) { const int b = e / (22 * 256), rem = e % (22 * 256), i = rem / 256, c4 = rem % 256;
            dst[((size_t)b * 30 + i) * 256 + c4] = st[((size_t)b * 30 + i + 8) * 256 + c4]; }
    }
}
__device__ __forceinline__ void phase0_mod(const Params& P, LAS unsigned char* lds) {
    const int tid = opaque_tid(), lane = tid & 63, wave = tid >> 6, G = gridDim.x, bid = blockIdx.x;
    unsigned char* ws = P.ws;
    {
        const int fr = lane & 15, fq = lane >> 4;
        LAS float* red = (LAS float*)lds;
        const float* wada = P.in[8]; const float* bada = P.in[9];
        const bf16_t* sch = (const bf16_t*)(ws + WS_SCH); const bf16_t* scl = (const bf16_t*)(ws + WS_SCL);
        float* mod = (float*)(ws + WS_MOD);
        for (int task = bid; task < NMOD / 32; task += G) {
            const int n0 = task * 32, kbase = wave * 128;
            f32x4 acc[2][9];
#pragma unroll
            for (int t = 0; t < 2; ++t)
#pragma unroll
                for (int i = 0; i < 9; ++i) acc[t][i] = (f32x4){0.f, 0.f, 0.f, 0.f};
#pragma unroll 1
            for (int ks = 0; ks < 4; ++ks) {
                const int k0 = kbase + ks * 32 + fq * 8;
                float bv0[8], bv1[8];
#pragma unroll
                for (int i = 0; i < 8; ++i) { bv0[i] = wada[(size_t)(k0 + i) * NMOD + n0 + fr]; bv1[i] = wada[(size_t)(k0 + i) * NMOD + n0 + 16 + fr]; }
                bf16x8 ah[9], al[9];
#pragma unroll
                for (int rt = 0; rt < 9; ++rt) { ah[rt] = *(const bf16x8*)(sch + (size_t)(rt * 16 + fr) * 1024 + k0); al[rt] = *(const bf16x8*)(scl + (size_t)(rt * 16 + fr) * 1024 + k0); }
                bf16x8 bh0, bl0, bh1, bl1; split8(bv0, bh0, bl0); split8(bv1, bh1, bl1);
#pragma unroll
                for (int rt = 0; rt < 9; ++rt) {
                    acc[0][rt] = __builtin_amdgcn_mfma_f32_16x16x32_bf16(ah[rt], bh0, acc[0][rt], 0, 0, 0);
                    acc[0][rt] = __builtin_amdgcn_mfma_f32_16x16x32_bf16(al[rt], bh0, acc[0][rt], 0, 0, 0);
                    acc[0][rt] = __builtin_amdgcn_mfma_f32_16x16x32_bf16(ah[rt], bl0, acc[0][rt], 0, 0, 0);
                    acc[1][rt] = __builtin_amdgcn_mfma_f32_16x16x32_bf16(ah[rt], bh1, acc[1][rt], 0, 0, 0);
                    acc[1][rt] = __builtin_amdgcn_mfma_f32_16x16x32_bf16(al[rt], bh1, acc[1][rt], 0, 0, 0);
                    acc[1][rt] = __builtin_amdgcn_mfma_f32_16x16x32_bf16(ah[rt], bl1, acc[1][rt], 0, 0, 0);
                }
            }
#pragma unroll
            for (int t = 0; t < 2; ++t) {
#pragma unroll
                for (int rt = 0; rt < 9; ++rt)
#pragma unroll
                    for (int j = 0; j < 4; ++j) red[(wave * 144 + rt * 16 + fq * 4 + j) * 16 + fr] = acc[t][rt][j];
                __syncthreads();
                for (int idx = tid; idx < NBATCH * 16; idx += NTHREADS) { const int row = idx >> 4, col = idx & 15;
                    float s = bada[n0 + t * 16 + col];
#pragma unroll
                    for (int w = 0; w < 8; ++w) s += red[(w * 144 + row) * 16 + col];
                    mod[(size_t)row * NMOD + n0 + t * 16 + col] = s; }
                __syncthreads();
            }
        }
    }
    weight_transposes(P, lds, TI0, TI5, 64);
}

template <int MODE>
__device__ __forceinline__ void phase_norm(const float* xp, const float* xs, const bf16_t* xb, const float* g, const float* mod, int shift_off, int scale_off, bf16_t* dst, float* ydst) {
    const int tid = opaque_tid(), lane = tid & 63, wave = tid >> 6;
    const int gw = blockIdx.x * NWAVES + wave, NGW = gridDim.x * NWAVES;
    for (int row0 = gw; row0 < MT; row0 += 2 * NGW) {
        f32x4 v[2][4], gv[4], sc[2][4], sh[2][4];
        int rows[2]; rows[0] = row0; rows[1] = (row0 + NGW < MT) ? row0 + NGW : row0;
#pragma unroll
        for (int j = 0; j < 4; ++j) gv[j] = *(const f32x4*)(g + 4 * lane + 256 * j);
#pragma unroll
        for (int t = 0; t < 2; ++t) {
            const int row = rows[t];
            if (MODE == 0) { const float* xr = (row < MP) ? xp + (size_t)row * 1024 : xs + (size_t)(row - MP) * 1024;
#pragma unroll
                for (int j = 0; j < 4; ++j) v[t][j] = *(const f32x4*)(xr + 4 * lane + 256 * j); }
            else {
#pragma unroll
                for (int j = 0; j < 4; ++j) { const u32x2 w = *(const u32x2*)(xb + (size_t)row * 1024 + 4 * lane + 256 * j); v[t][j] = (f32x4){bf_lo(w.x), bf_hi(w.x), bf_lo(w.y), bf_hi(w.y)}; } }
            if (MODE != 2) { const float* mp = mod + (size_t)batch_of_row(row) * NMOD;
#pragma unroll
                for (int j = 0; j < 4; ++j) { sc[t][j] = *(const f32x4*)(mp + scale_off + 4 * lane + 256 * j); sh[t][j] = *(const f32x4*)(mp + shift_off + 4 * lane + 256 * j); } }
        }
#pragma unroll
        for (int t = 0; t < 2; ++t) {
            const int row = rows[t];
            float ss = 0.f;
#pragma unroll
            for (int j = 0; j < 4; ++j) ss += v[t][j][0] * v[t][j][0] + v[t][j][1] * v[t][j][1] + v[t][j][2] * v[t][j][2] + v[t][j][3] * v[t][j][3];
            const float rstd = rsqrtf(wave_sum(ss) * (1.0f / 1024.0f) + EPS);
#pragma unroll
            for (int j = 0; j < 4; ++j) {
                const int c = 4 * lane + 256 * j;
                if (MODE == 2) { *(f32x4*)(ydst + (size_t)row * 1024 + c) = v[t][j] * rstd * gv[j]; }
                else {
                    f32x4 o;
#pragma unroll
                    for (int i = 0; i < 4; ++i) o[i] = v[t][j][i] * rstd * gv[j][i] * (1.0f + sc[t][j][i]) + sh[t][j][i];
                    u32x2 w; w.x = pk_bf16(o[0], o[1]); w.y = pk_bf16(o[2], o[3]);
                    *(u32x2*)(dst + (size_t)row * 1024 + c) = w;
                }
            }
        }
    }
}

constexpr int RB_RAW = 0, RB_XRB = 21504, RB_SA = 43008, RB_SB = 84992, RB_CAR = 126976;
__device__ __forceinline__ float neg_expm1(float x) {
    const float p = -x * (1.0f + x * (0.5f + x * (0.16666667f + x * (0.041666668f + x * (0.008333334f + x * 0.0013888889f)))));
    return (x > -0.25f) ? p : 1.0f - __expf(x);
}
struct RgPre { u32x4 v[3]; float cst; };
__device__ __forceinline__ void rglru_prefetch(const Params& P, int q, int tid, RgPre& pre) {
    const bf16_t* rnnx = (const bf16_t*)(P.ws + WS_S2);
    const bool sample = q >= 2048;
    int g, r0, c = 0;
    if (!sample) { g = q & 7; c = (q >> 3) & 31; r0 = (q >> 8) * 2048 + c * 64; }
    else { const int qs = q - 2048; g = qs & 7; r0 = MP + (qs >> 3) * 64; }
#pragma unroll
    for (int u = 0; u < 3; ++u) { const int idx = u * NTHREADS + tid, i = idx / 20, ck = idx % 20;
        pre.v[u] = (u32x4){0u, 0u, 0u, 0u};
        const bool valid = (idx < 67 * 20) && (sample ? (i >= 3) : (c > 0 || i >= 3));
        if (valid) pre.v[u] = *(const u32x4*)(rnnx + (size_t)(r0 - 3 + i) * 1280 + g * 160 + ck * 8); }
    pre.cst = 0.f;
    if (tid < 480) { const int k = tid / 160, cc = tid % 160; const float* sp = (k == 0) ? P.in[20] : (k == 1 ? P.in[22] : (const float*)(P.ws + WS_SP8)); pre.cst = sp[g * 160 + cc]; }
}
__device__ __forceinline__ void rglru_task(const Params& P, LAS unsigned char* lds, int q, RgPre& pre, int qn) {
    const int tid = opaque_tid(), lane = tid & 63, wave = tid >> 6, fr = lane & 15, fq = lane >> 4;
    unsigned char* ws = P.ws;
    const bf16_t* rnnx = (const bf16_t*)(ws + WS_S2);
    bf16_t* gghg = (bf16_t*)(ws + WS_S3); bf16_t* pg = (bf16_t*)(ws + WS_S4);
    const bool sample = q >= 2048;
    int g, r0, b = 0, c = 0, sb0 = 0;
    if (!sample) { g = q & 7; c = (q >> 3) & 31; b = q >> 8; r0 = b * 2048 + c * 64; }
    else { const int qs = q - 2048; g = qs & 7; sb0 = (qs >> 3) * 8; r0 = MP + (qs >> 3) * 64; }
    LAS bf16_t* RAW = (LAS bf16_t*)(lds + RB_RAW);
    LAS bf16_t* XRB = (LAS bf16_t*)(lds + RB_XRB);
    LAS float* SA = (LAS float*)(lds + RB_SA);
    LAS float* SB = (LAS float*)(lds + RB_SB);
    LAS float* CAR = (LAS float*)(lds + RB_CAR);
    LAS float* CST = (LAS float*)(lds + LDS_STAGE);
    const bf16_t* wrg = (const bf16_t*)(ws + WS_WRG) + (size_t)g * 25600; const bf16_t* wig = (const bf16_t*)(ws + WS_WIG) + (size_t)g * 25600;
    int ctc = (wave * 5) >> 2;
    bf16x8 fwr[5], fwi[5];
#pragma unroll
    for (int ks = 0; ks < 5; ++ks) { fwr[ks] = *(const bf16x8*)(wrg + (size_t)(ctc * 16 + fr) * 160 + ks * 32 + fq * 8); fwi[ks] = *(const bf16x8*)(wig + (size_t)(ctc * 16 + fr) * 160 + ks * 32 + fq * 8); }
    if (tid < 480) CST[tid] = pre.cst;
#pragma unroll
    for (int u = 0; u < 3; ++u) { const int idx = u * NTHREADS + tid, i = idx / 20, ck = idx % 20;
        if (idx < 67 * 20) *(LAS u32x4*)(RAW + i * 160 + ck * 8) = pre.v[u]; }
    __syncthreads();
    if (tid < 480) {
        const int cp = tid % 80, rg = tid / 80, ch = cp * 2, chg = g * 160 + ch;
        const f32x2 bs = *(const f32x2*)(P.in[18] + chg);
        f32x2 w[4];
#pragma unroll
        for (int j = 0; j < 4; ++j) w[j] = *(const f32x2*)(P.in[17] + (size_t)j * 1280 + chg);
        const int lr0 = rg * 11, lr1 = (lr0 + 11 < 64) ? lr0 + 11 : 64;
        if (!sample) {
            unsigned x0 = *(const LAS unsigned*)(RAW + (lr0 + 0) * 160 + ch), x1 = *(const LAS unsigned*)(RAW + (lr0 + 1) * 160 + ch), x2 = *(const LAS unsigned*)(RAW + (lr0 + 2) * 160 + ch);
            for (int lr = lr0; lr < lr1; ++lr) {
                const unsigned x3 = *(const LAS unsigned*)(RAW + (lr + 3) * 160 + ch);
                const float a0 = bs[0] + w[0][0] * bf_lo(x0) + w[1][0] * bf_lo(x1) + w[2][0] * bf_lo(x2) + w[3][0] * bf_lo(x3);
                const float a1 = bs[1] + w[0][1] * bf_hi(x0) + w[1][1] * bf_hi(x1) + w[2][1] * bf_hi(x2) + w[3][1] * bf_hi(x3);
                *(LAS unsigned*)(XRB + lr * 168 + ch) = pk_bf16(a0, a1);
                x0 = x1; x1 = x2; x2 = x3;
            }
        } else {
            for (int lr = lr0; lr < lr1; ++lr) {
                const int t = lr & 7;
                f32x2 a = bs;
#pragma unroll
                for (int j = 0; j < 4; ++j) {
                    float x0, x1;
                    if (t + j < 3) { const f32x2 sv = *(const f32x2*)(P.in[3] + ((size_t)(sb0 + (lr >> 3)) * 3 + t + j) * 1280 + chg); x0 = sv[0]; x1 = sv[1]; }
                    else { const unsigned rw = *(const LAS unsigned*)(RAW + (lr + j) * 160 + ch); x0 = bf_lo(rw); x1 = bf_hi(rw); }
                    a[0] += w[j][0] * x0; a[1] += w[j][1] * x1;
                }
                *(LAS unsigned*)(XRB + lr * 168 + ch) = pk_bf16(a[0], a[1]);
            }
        }
    }
    __syncthreads();
    if (qn >= 0) rglru_prefetch(P, qn, tid, pre);
    u32x4 gpre[3];
#pragma unroll
    for (int u = 0; u < 3; ++u) { const int idx = u * NTHREADS + tid; gpre[u] = (u32x4){0u, 0u, 0u, 0u};
        if (idx < 64 * 20) gpre[u] = *(const u32x4*)(gghg + (size_t)(r0 + idx / 20) * 1280 + g * 160 + (idx % 20) * 8); }
    {
#pragma unroll
        for (int i = 0; i < 5; ++i) {
            const int idx = wave * 5 + i, ct = idx >> 2, rt = idx & 3;
            if (ct != ctc) { ctc = ct;
#pragma unroll
                for (int ks = 0; ks < 5; ++ks) { fwr[ks] = *(const bf16x8*)(wrg + (size_t)(ct * 16 + fr) * 160 + ks * 32 + fq * 8); fwi[ks] = *(const bf16x8*)(wig + (size_t)(ct * 16 + fr) * 160 + ks * 32 + fq * 8); } }
            f32x4 ar = {0.f, 0.f, 0.f, 0.f}, ai = {0.f, 0.f, 0.f, 0.f};
#pragma unroll
            for (int ks = 0; ks < 5; ++ks) {
                const bf16x8 xb = *(const LAS bf16x8*)(XRB + (rt * 16 + fr) * 168 + ks * 32 + fq * 8);
                ar = __builtin_amdgcn_mfma_f32_16x16x32_bf16(fwr[ks], xb, ar, 0, 0, 0);
                ai = __builtin_amdgcn_mfma_f32_16x16x32_bf16(fwi[ks], xb, ai, 0, 0, 0);
            }
            const int chl = ct * 16 + fq * 4, chg = g * 160 + chl, lr = rt * 16 + fr;
            const f32x4 brg = *(const LAS f32x4*)(CST + chl), big = *(const LAS f32x4*)(CST + 160 + chl), sp8 = *(const LAS f32x4*)(CST + 320 + chl);
            const u32x2 xw = *(const LAS u32x2*)(XRB + lr * 168 + chl);
            const float xr[4] = {bf_lo(xw.x), bf_hi(xw.x), bf_lo(xw.y), bf_hi(xw.y)};
            f32x4 av, bx;
#pragma unroll
            for (int jp = 0; jp < 2; ++jp) {
                const f32x2 zr = {ar[2 * jp] + brg[2 * jp], ar[2 * jp + 1] + brg[2 * jp + 1]}, zi = {ai[2 * jp] + big[2 * jp], ai[2 * jp + 1] + big[2 * jp + 1]};
                const f32x2 r = sigmoid2(zr), ig = sigmoid2(zi);
                const f32x2 sp = {sp8[2 * jp], sp8[2 * jp + 1]}, xv = {xr[2 * jp], xr[2 * jp + 1]};
                const f32x2 la = -(r * sp);
                const f32x2 tl = la * 1.4426950408889634f;
                av[2 * jp] = __builtin_amdgcn_exp2f(tl.x); av[2 * jp + 1] = __builtin_amdgcn_exp2f(tl.y);
                const f32x2 x2 = la + la;
                f32x2 m2 = -x2 * (1.0f + x2 * (0.5f + x2 * (0.16666667f + x2 * (0.041666668f + x2 * (0.008333334f + x2 * 0.0013888889f)))));
                if (__builtin_amdgcn_ballot_w64(x2.x <= -0.25f || x2.y <= -0.25f) != 0ull) {
                    m2.x = (x2.x > -0.25f) ? m2.x : 1.0f - __expf(x2.x); m2.y = (x2.y > -0.25f) ? m2.y : 1.0f - __expf(x2.y); }
                f32x2 sq; sq.x = __builtin_sqrtf(m2.x); sq.y = __builtin_sqrtf(m2.y);
                const f32x2 bxv = sq * ig * xv;
                bx[2 * jp] = bxv.x; bx[2 * jp + 1] = bxv.y;
            }
            *(LAS f32x4*)(SA + lr * 164 + chl) = av; *(LAS f32x4*)(SB + lr * 164 + chl) = bx;
        }
    }
    __syncthreads();
    if (tid < 480) {
        const int ch = tid % 160, sg = tid / 160, chg = g * 160 + ch;
        if (!sample) {
            const int lr0 = sg == 0 ? 0 : (sg == 1 ? 22 : 43), lr1 = sg == 0 ? 22 : (sg == 1 ? 43 : 64);
            float h = 0.f, pr = 1.f;
            float av[22], bv[22];
#pragma unroll
            for (int i = 0; i < 22; ++i) { const int lr = (lr0 + i < lr1) ? lr0 + i : lr1 - 1; av[i] = SA[lr * 164 + ch]; bv[i] = SB[lr * 164 + ch]; }
#pragma unroll
            for (int i = 0; i < 22; ++i) { if (lr0 + i < lr1) { h = av[i] * h + bv[i]; pr *= av[i]; } bv[i] = h; av[i] = pr; }
#pragma unroll
            for (int i = 0; i < 22; ++i) { if (lr0 + i < lr1) { SB[(lr0 + i) * 164 + ch] = bv[i]; SA[(lr0 + i) * 164 + ch] = av[i]; } }
            CAR[sg * 160 + ch] = h; CAR[480 + sg * 160 + ch] = pr;
        } else {
            const int s0 = sg * 3, s1 = (s0 + 3 < 8) ? s0 + 3 : 8;
            for (int s = s0; s < s1; ++s) {
                float h = P.in[4][(size_t)(sb0 + s) * 1280 + chg];
#pragma unroll
                for (int t = 0; t < 8; ++t) { const int lr = s * 8 + t; h = SA[lr * 164 + ch] * h + SB[lr * 164 + ch]; SB[lr * 164 + ch] = h; }
                P.out[O_H_S + (size_t)(sb0 + s) * 1280 + chg] = h;
            }
        }
    }
    __syncthreads();
    if (!sample && tid < 160) {
        const float h0 = CAR[tid], h1 = CAR[160 + tid], h2 = CAR[320 + tid], p0 = CAR[480 + tid], p1 = CAR[640 + tid], p2 = CAR[800 + tid];
        const float c1 = h0, c2 = h1 + p1 * c1;
        ((float*)(ws + WS_HL))[((size_t)b * 32 + c) * 1280 + g * 160 + tid] = h2 + p2 * c2;
        ((float*)(ws + WS_PL))[((size_t)b * 32 + c) * 1280 + g * 160 + tid] = p0 * p1 * p2;
    }
#pragma unroll
    for (int u = 0; u < 3; ++u) { const int idx = u * NTHREADS + tid; if (idx >= 64 * 20) break; const int lr = idx / 20, ch = (idx % 20) * 8;
        const size_t off = (size_t)(r0 + lr) * 1280 + g * 160 + ch;
        const u32x4 gw = gpre[u];
        const float gv[8] = {bf_lo(gw.x), bf_hi(gw.x), bf_lo(gw.y), bf_hi(gw.y), bf_lo(gw.z), bf_hi(gw.z), bf_lo(gw.w), bf_hi(gw.w)};
        f32x4 h0 = *(const LAS f32x4*)(SB + lr * 164 + ch), h1 = *(const LAS f32x4*)(SB + lr * 164 + ch + 4);
        if (!sample) {
            f32x4 p0 = *(const LAS f32x4*)(SA + lr * 164 + ch), p1 = *(const LAS f32x4*)(SA + lr * 164 + ch + 4);
            if (lr >= 22) {
                const int sg = lr >= 43 ? 2 : 1;
#pragma unroll
                for (int k = 0; k < 2; ++k) {
                    const f32x4 e0 = *(const LAS f32x4*)(CAR + ch + 4 * k), q0 = *(const LAS f32x4*)(CAR + 480 + ch + 4 * k);
                    f32x4 cin = e0, qin = q0;
                    if (sg == 2) { const f32x4 e1 = *(const LAS f32x4*)(CAR + 160 + ch + 4 * k), q1 = *(const LAS f32x4*)(CAR + 640 + ch + 4 * k); cin = e1 + q1 * e0; qin = q0 * q1; }
                    if (k == 0) { h0 = h0 + p0 * cin; p0 = p0 * qin; } else { h1 = h1 + p1 * cin; p1 = p1 * qin; }
                }
            }
            u32x4 o2; o2.x = pk_bf16(p0[0] * gv[0], p0[1] * gv[1]); o2.y = pk_bf16(p0[2] * gv[2], p0[3] * gv[3]); o2.z = pk_bf16(p1[0] * gv[4], p1[1] * gv[5]); o2.w = pk_bf16(p1[2] * gv[6], p1[3] * gv[7]);
            *(u32x4*)(pg + off) = o2;
        }
        u32x4 o; o.x = pk_bf16(h0[0] * gv[0], h0[1] * gv[1]); o.y = pk_bf16(h0[2] * gv[2], h0[3] * gv[3]); o.z = pk_bf16(h1[0] * gv[4], h1[1] * gv[5]); o.w = pk_bf16(h1[2] * gv[6], h1[3] * gv[7]);
        *(u32x4*)(gghg + off) = o; }
    __syncthreads();
}

template <int R>
__device__ __forceinline__ void conf_task(const Params& P, LAS unsigned char* lds, int r0, int t0, int sb, bool sample, const f32x2 (&w)[31], f32x2 bias) {
    const int tid = opaque_tid(), lane = tid & 63, wave = tid >> 6;
    const bf16_t* uglu = (const bf16_t*)(P.ws + WS_S1);
    bf16_t* ua = (bf16_t*)(P.ws + WS_S0);
    LAS bf16_t* ST = (LAS bf16_t*)lds;
    {
        constexpr int NCH = (R + 30) * 128, PER = (NCH + NTHREADS - 1) / NTHREADS, NB = PER / 2;
#pragma unroll
        for (int h = 0; h < 2; ++h) {
            u32x4 v[NB]; f32x4 fa[NB], fb[NB];
#pragma unroll
            for (int u = 0; u < NB; ++u) {
                const int idx = (h * NB + u) * NTHREADS + tid, i = idx >> 7, ck = idx & 127;
                v[u] = (u32x4){0u, 0u, 0u, 0u}; fa[u] = (f32x4){0.f, 0.f, 0.f, 0.f}; fb[u] = fa[u];
                if (idx < NCH) {
                    if (!sample) { if (t0 - 30 + i >= 0) v[u] = *(const u32x4*)(uglu + (size_t)(r0 - 30 + i) * 1024 + ck * 8); }
                    else if (i < 30) { const float* sp = P.in[2] + ((size_t)sb * 30 + i) * 1024 + ck * 8; fa[u] = *(const f32x4*)sp; fb[u] = *(const f32x4*)(sp + 4); }
                    else v[u] = *(const u32x4*)(uglu + (size_t)(r0 + i - 30) * 1024 + ck * 8);
                }
            }
#pragma unroll
            for (int u = 0; u < NB; ++u) {
                const int idx = (h * NB + u) * NTHREADS + tid, i = idx >> 7, ck = idx & 127;
                if (idx < NCH) {
                    u32x4 o = v[u];
                    if (sample && i < 30) { o.x = pk_bf16(fa[u][0], fa[u][1]); o.y = pk_bf16(fa[u][2], fa[u][3]); o.z = pk_bf16(fb[u][0], fb[u][1]); o.w = pk_bf16(fb[u][2], fb[u][3]); }
                    *(LAS u32x4*)(ST + i * 1024 + ck * 8) = o;
                }
            }
        }
    }
    __syncthreads();
    f32x2 acc[R];
#pragma unroll
    for (int r = 0; r < R; ++r) acc[r] = bias;
#pragma unroll
    for (int i = 0; i < R + 30; ++i) {
        const unsigned rw = *(const LAS unsigned*)(ST + i * 1024 + 2 * tid);
        const f32x2 v = {bf_lo(rw), bf_hi(rw)};
#pragma unroll
        for (int r = 0; r < R; ++r) { const int tap = i - r; if (tap >= 0 && tap <= 30) acc[r] += v * w[tap]; }
    }
    __syncthreads();
    LAS float* CO = (LAS float*)lds;
#pragma unroll
    for (int r = 0; r < R; ++r) *(LAS f32x2*)(CO + r * 1024 + 2 * tid) = acc[r];
    __syncthreads();
    for (int r = wave; r < R; r += NWAVES) {
        f32x4 v[4]; float s = 0.f;
#pragma unroll
        for (int k = 0; k < 4; ++k) { v[k] = *(const LAS f32x4*)(CO + r * 1024 + 4 * lane + 256 * k); s += (v[k][0] + v[k][1]) + (v[k][2] + v[k][3]); }
        const float mean = wave_sum(s) * (1.0f / 1024.0f); float s2 = 0.f;
#pragma unroll
        for (int k = 0; k < 4; ++k) { v[k] = v[k] - mean; s2 += (v[k][0] * v[k][0] + v[k][1] * v[k][1]) + (v[k][2] * v[k][2] + v[k][3] * v[k][3]); }
        const float rstd = rsqrtf(wave_sum(s2) * (1.0f / 1024.0f) + EPS);
#pragma unroll
        for (int k = 0; k < 4; ++k) { const int c = 4 * lane + 256 * k;
            const f32x4 gv = *(const f32x4*)(P.in[14] + c), bv = *(const f32x4*)(P.in[15] + c);
            float o[4];
#pragma unroll
            for (int i = 0; i < 4; ++i) o[i] = siluf_(v[k][i] * rstd * gv[i] + bv[i]);
            u32x2 wv; wv.x = pk_bf16(o[0], o[1]); wv.y = pk_bf16(o[2], o[3]);
            *(u32x2*)(ua + (size_t)(r0 + r) * 1024 + c) = wv; }
    }
    __syncthreads();
}

__device__ __forceinline__ void fix_task(const Params& P, LAS unsigned char* lds, int q) {
    const int tid = opaque_tid();
    const int b = q / 31, c = 1 + q % 31;
    LAS float* Hs = (LAS float*)lds;
    const float* hl = (const float*)(P.ws + WS_HL) + (size_t)b * 32 * 1280; const float* pl = (const float*)(P.ws + WS_PL) + (size_t)b * 32 * 1280;
    for (int ch = tid; ch < 1280; ch += NTHREADS) {
        float hv[32], pv[32];
#pragma unroll
        for (int cc = 0; cc < 32; ++cc) { const int ce = cc <= c ? cc : c; hv[cc] = hl[(size_t)ce * 1280 + ch]; pv[cc] = pl[(size_t)ce * 1280 + ch]; }
        float H = 0.f;
#pragma unroll
        for (int cc = 0; cc < 31; ++cc) H = (cc < c) ? hv[cc] + pv[cc] * H : H;
        Hs[ch] = H;
        if (c == 31) P.out[O_H_P + (size_t)b * 1280 + ch] = hv[31] + pv[31] * H;
    }
    __syncthreads();
    bf16_t* hg = (bf16_t*)(P.ws + WS_S3); const bf16_t* pg = (const bf16_t*)(P.ws + WS_S4);
    const int r0 = b * 2048 + c * 64;
    for (int base = 0; base < 64 * 160; base += 4 * NTHREADS) {
        u32x4 hw[4], pw[4];
#pragma unroll
        for (int u = 0; u < 4; ++u) { const int idx = base + u * NTHREADS + tid, lr = idx / 160, ch = (idx % 160) * 8; const size_t off = (size_t)(r0 + lr) * 1280 + ch;
            hw[u] = *(const u32x4*)(hg + off); pw[u] = *(const u32x4*)(pg + off); }
#pragma unroll
        for (int u = 0; u < 4; ++u) { const int idx = base + u * NTHREADS + tid, lr = idx / 160, ch = (idx % 160) * 8; const size_t off = (size_t)(r0 + lr) * 1280 + ch;
            const f32x4 H0 = *(const LAS f32x4*)(Hs + ch), H1 = *(const LAS f32x4*)(Hs + ch + 4);
            u32x4 o;
            o.x = pk_bf16(bf_lo(hw[u].x) + bf_lo(pw[u].x) * H0[0], bf_hi(hw[u].x) + bf_hi(pw[u].x) * H0[1]);
            o.y = pk_bf16(bf_lo(hw[u].y) + bf_lo(pw[u].y) * H0[2], bf_hi(hw[u].y) + bf_hi(pw[u].y) * H0[3]);
            o.z = pk_bf16(bf_lo(hw[u].z) + bf_lo(pw[u].z) * H1[0], bf_hi(hw[u].z) + bf_hi(pw[u].z) * H1[1]);
            o.w = pk_bf16(bf_lo(hw[u].w) + bf_lo(pw[u].w) * H1[2], bf_hi(hw[u].w) + bf_hi(pw[u].w) * H1[3]);
            *(u32x4*)(hg + off) = o; }
    }
    __syncthreads();
}

template <int K>
__device__ __forceinline__ void small_gemm(LAS unsigned char* lds, const bf16_t* A, const bf16_t* Bt, int m0, int n0, int tid, f32x4 (&acc)[2]) {
    static_assert(K % 128 == 0, "K multiple of 128");
    constexpr int RS = 272, ABYTES = 128 * RS, BUF = 160 * RS;
    const int lane = tid & 63, wave = tid >> 6, fr = lane & 15, fq = lane >> 4;
    const int srow = tid >> 4, sc = tid & 15;
    const bf16_t* ga = A + (size_t)(m0 + srow) * K + sc * 8;
    const bf16_t* gb = Bt + (size_t)(n0 + srow) * K + sc * 8;
    static_assert((K / 128) % 2 == 0, "even number of K-chunks");
    u32x4 r0[4], r0b, r1[4], r1b;
#define SG_LOAD(R, RB, c) do { _Pragma("unroll") for (int u = 0; u < 4; ++u) R[u] = *(const u32x4*)(ga + (size_t)(32 * u) * K + (c) * 128); RB = *(const u32x4*)(gb + (c) * 128); } while (0)
#define SG_STORE(R, RB, buf) do { _Pragma("unroll") for (int u = 0; u < 4; ++u) *(LAS u32x4*)((buf) + (srow + 32 * u) * RS + sc * 16) = R[u]; *(LAS u32x4*)((buf) + ABYTES + srow * RS + sc * 16) = RB; } while (0)
#define SG_COMPUTE(buf) do { _Pragma("unroll") for (int ks = 0; ks < 4; ++ks) { \
        const bf16x8 a = *(const LAS bf16x8*)((buf) + aoff + ks * 64), b0 = *(const LAS bf16x8*)((buf) + boff + ks * 64), b1 = *(const LAS bf16x8*)((buf) + boff + 16 * RS + ks * 64); \
        acc[0] = __builtin_amdgcn_mfma_f32_16x16x32_bf16(b0, a, acc[0], 0, 0, 0); acc[1] = __builtin_amdgcn_mfma_f32_16x16x32_bf16(b1, a, acc[1], 0, 0, 0); } } while (0)
    const int aoff = (wave * 16 + fr) * RS + fq * 16, boff = ABYTES + fr * RS + fq * 16;
    LAS unsigned char* buf0 = lds; LAS unsigned char* buf1 = lds + BUF;
    SG_LOAD(r0, r0b, 0); SG_LOAD(r1, r1b, 1);
    SG_STORE(r0, r0b, buf0);
    __syncthreads();
#pragma unroll 1
    for (int kc = 0; kc < K / 128; kc += 2) {
        if (kc + 2 < K / 128) SG_LOAD(r0, r0b, kc + 2);
        SG_COMPUTE(buf0);
        SG_STORE(r1, r1b, buf1);
        __syncthreads();
        if (kc + 3 < K / 128) SG_LOAD(r1, r1b, kc + 3);
        SG_COMPUTE(buf1);
        if (kc + 2 < K / 128) SG_STORE(r0, r0b, buf0);
        __syncthreads();
    }
#undef SG_LOAD
#undef SG_STORE
#undef SG_COMPUTE
}

#define XB_TMO      128
#define XB_XCNT(j)  (256  + 64 * (j))
#define XB_XSUB(j)  (1280 + 64 * (j))
#define XB_XGEN(j)  (2304 + 64 * (j))
#define XB_TOP      3328
#define XB_TOPGEN   3392
#define XCD_BAR_WORDS 3456
#define XB_SPIN_CAP (1u << 18)
__device__ __forceinline__ unsigned xb_ld(unsigned* p)              { return __hip_atomic_load(p, __ATOMIC_RELAXED, __HIP_MEMORY_SCOPE_AGENT); }
__device__ __forceinline__ unsigned xb_add(unsigned* p, unsigned v) { return __hip_atomic_fetch_add(p, v, __ATOMIC_RELAXED, __HIP_MEMORY_SCOPE_AGENT); }
__device__ __forceinline__ unsigned xb_xcc_id() { return (unsigned)__builtin_amdgcn_s_getreg((3 << 11) | 20) & 0xFu; }
#define XB_SPIN(cond, bar) do { unsigned _sp = 0; while (cond) { __builtin_amdgcn_s_sleep(1); \
    if ((++_sp & 255u) == 0u) { if (xb_ld(&(bar)[XB_TMO])) break; if (_sp > XB_SPIN_CAP) { atomicAdd(&(bar)[XB_TMO], 1u); break; } } } } while (0)
struct XcdBarrier { unsigned* bar; unsigned x; volatile LAS unsigned* st; };
__device__ __forceinline__ XcdBarrier xcd_barrier_post(unsigned* bar, volatile LAS unsigned* st) {
    XcdBarrier b; b.bar = bar; b.x = xb_xcc_id(); b.st = st;
    if (threadIdx.x == 0) (void)xb_add(&bar[XB_XCNT(b.x)], 1u);
    return b;
}
__device__ __forceinline__ void xcd_barrier_complete(unsigned* bar, unsigned x, unsigned& nloc, unsigned& nx) {
    const unsigned G = gridDim.x * gridDim.y * gridDim.z;
    unsigned sum, cnt, mine, sp = 0u;
    for (;;) {
        sum = 0u; cnt = 0u; mine = 0u;
#pragma unroll
        for (unsigned j = 0; j < 16; ++j) { const unsigned c = xb_ld(&bar[XB_XCNT(j)]); sum += c; cnt += (c > 0u) ? 1u : 0u; mine = (j == x) ? c : mine; }
        if (sum == G) break;
        __builtin_amdgcn_s_sleep(1);
        if ((++sp & 255u) == 0u) { if (xb_ld(&bar[XB_TMO])) break; if (sp > XB_SPIN_CAP) { atomicAdd(&bar[XB_TMO], 1u); break; } }
    }
    nloc = mine > 0u ? mine : 1u; nx = cnt > 0u ? cnt : 1u;
}
__device__ __forceinline__ void xcd_barrier(const XcdBarrier& b) {
    asm volatile("s_waitcnt vmcnt(0)" ::: "memory");
    __syncthreads();
    if (threadIdx.x == 0) {
        unsigned* bar = b.bar;
        __builtin_amdgcn_s_waitcnt(0);
        unsigned nloc = b.st[0], nx = b.st[1];
        if (nloc == 0u) { xcd_barrier_complete(bar, b.x, nloc, nx); b.st[0] = nloc; b.st[1] = nx; }
        const unsigned old = xb_add(&bar[XB_XSUB(b.x)], 1u);
        const unsigned gen = old / nloc;
        if (old + 1u == (gen + 1u) * nloc) {
            __builtin_amdgcn_fence(__ATOMIC_RELEASE, "agent");
            asm volatile("s_waitcnt vmcnt(0)" ::: "memory");
            const unsigned og = xb_add(&bar[XB_TOP], 1u);
            const unsigned tg = og / nx;
            if (og + 1u == (tg + 1u) * nx) xb_add(&bar[XB_TOPGEN], 1u);
            else XB_SPIN(xb_ld(&bar[XB_TOPGEN]) == tg, bar);
            __builtin_amdgcn_fence(__ATOMIC_ACQUIRE, "agent");
            xb_add(&bar[XB_XGEN(b.x)], 1u);
            asm volatile("s_waitcnt vmcnt(0)" ::: "memory");
        } else {
            XB_SPIN(xb_ld(&bar[XB_XGEN(b.x)]) == gen, bar);
            __builtin_amdgcn_fence(__ATOMIC_ACQUIRE, "agent");
            asm volatile("s_waitcnt vmcnt(0)" ::: "memory");
        }
    }
    __syncthreads();
}

__global__ void __launch_bounds__(NTHREADS, 2) fwd_megakernel(Params P) {
    extern __shared__ __attribute__((aligned(16))) unsigned char lds_raw[];
    LAS unsigned char* lds = (LAS unsigned char*)lds_raw;
    cg::grid_group grid = cg::this_grid();
    const int tid = threadIdx.x, G = gridDim.x, bid = blockIdx.x;
    unsigned char* ws = P.ws;
    float* mod = (float*)(ws + WS_MOD);
    bf16_t* xmid = (bf16_t*)(ws + WS_S3);
    if (tid < 4) ((LAS unsigned*)(lds + LDS_BARW))[tid] = 0u;
    __syncthreads();
    const XcdBarrier xbar = xcd_barrier_post((unsigned*)(ws + WS_BAR), (volatile LAS unsigned*)(lds + LDS_BARW));
    if (P.ws == nullptr) grid.sync();

    for (int rep = 0; rep < REPS(0); ++rep) { phase0(P, lds); xcd_barrier(xbar); phase0_mod(P, lds); xcd_barrier(xbar); }
    phase_norm<0>(P.in[0], P.in[1], nullptr, P.in[10], mod, 0, 1024, (bf16_t*)(ws + WS_S0), nullptr);
    xcd_barrier(xbar);
    for (int rep = 0; rep < REPS(2); ++rep) {
        if (rep) xcd_barrier(xbar);
        pg8::Gemm g{(const bf16_t*)(ws + WS_S0), (const bf16_t*)(ws + WS_WIN), MT, DIN, 1024}; pg8::StaticOrder S; S.init(MT, DIN, G, bid);
        EpiIn E{(bf16_t*)(ws + WS_S1), (bf16_t*)(ws + WS_S2), (bf16_t*)(ws + WS_S3), (bf16_t*)(P.out + O_Y), (bf16_t*)(P.out + O_Y) + (size_t)MT * 1024, P.out};
        pg8::gemm_phase<EpiIn>(lds, g, S, E);
    }
    xcd_barrier(xbar);
    {
        const int vb = (G % 8 == 0) ? (bid % 8) * (G / 8) + bid / 8 : bid;
        { RgPre pre; if (vb < 2176) rglru_prefetch(P, vb, opaque_tid(), pre);
          for (int q = vb; q < 2176; q += G) rglru_task(P, lds, q, pre, (q + G < 2176) ? q + G : -1); }
        f32x2 w[31];
#pragma unroll
        for (int j = 0; j < 31; ++j) w[j] = *(const f32x2*)(P.in[12] + (size_t)j * 1024 + 2 * tid);
        const f32x2 bias = *(const f32x2*)(P.in[13] + 2 * tid);
        for (int rep = 0; rep < REPS(3); ++rep)
        for (int q = (vb + G / 2) % G; q < 1152; q += G) {
            if (q < 1024) { const int b = q >> 7, t0 = (q & 127) * 16; conf_task<16>(P, lds, b * 2048 + t0, t0, 0, false, w, bias); }
            else { const int sb = q - 1024; conf_task<8>(P, lds, MP + sb * 8, 0, sb, true, w, bias); }
        }
    }
    xcd_barrier(xbar);
    for (int q = bid; q < 248; q += G) fix_task(P, lds, q);
    xcd_barrier(xbar);
    for (int rep = 0; rep < REPS(5); ++rep) {
        if (rep) xcd_barrier(xbar);
        pg8::StaticOrder S; S.init(MP, 1024, G, bid);
        { pg8::Gemm g{(const bf16_t*)(ws + WS_S0), (const bf16_t*)(ws + WS_WCA), MP, 1024, 1024};
          EpiMerge<0> E{(bf16_t*)(ws + WS_S1), (const bf16_t*)(P.out + O_Y)}; pg8::gemm_phase<EpiMerge<0>>(lds, g, S, E); }
        { pg8::Gemm g{(const bf16_t*)(ws + WS_S3), (const bf16_t*)(ws + WS_WRB), MP, 1024, 1280};
          EpiMerge<1> E{(bf16_t*)(ws + WS_S1), (const bf16_t*)(P.out + O_Y) + (size_t)MT * 1024}; pg8::gemm_phase<EpiMerge<1>>(lds, g, S, E); }
        {
            const int t2 = opaque_tid(), lane = t2 & 63, wave = t2 >> 6, fr = lane & 15, fq = lane >> 4;
            const bf16_t* sga = (const bf16_t*)(P.out + O_Y); const bf16_t* sgb = sga + (size_t)MT * 1024; bf16_t* mg = (bf16_t*)(ws + WS_S1);
            for (int t = bid; t < 256; t += G) {
                const int m0 = MP + (t >> 5) * 128, n0 = (t & 31) * 32;
                f32x4 a1[2] = {{0.f, 0.f, 0.f, 0.f}, {0.f, 0.f, 0.f, 0.f}}, a2[2] = {{0.f, 0.f, 0.f, 0.f}, {0.f, 0.f, 0.f, 0.f}};
                small_gemm<1024>(lds, (const bf16_t*)(ws + WS_S0), (const bf16_t*)(ws + WS_WCA), m0, n0, t2, a1);
                small_gemm<1280>(lds, (const bf16_t*)(ws + WS_S3), (const bf16_t*)(ws + WS_WRB), m0, n0, t2, a2);
#pragma unroll
                for (int ct = 0; ct < 2; ++ct) { const size_t off = (size_t)(m0 + wave * 16 + fr) * 1024 + n0 + ct * 16 + 4 * fq;
                    const u32x2 ga = *(const u32x2*)(sga + off), gb = *(const u32x2*)(sgb + off);
                    u32x2 o; o.x = pk_bf16(a1[ct][0] * bf_lo(ga.x) + a2[ct][0] * bf_lo(gb.x), a1[ct][1] * bf_hi(ga.x) + a2[ct][1] * bf_hi(gb.x));
                    o.y = pk_bf16(a1[ct][2] * bf_lo(ga.y) + a2[ct][2] * bf_lo(gb.y), a1[ct][3] * bf_hi(ga.y) + a2[ct][3] * bf_hi(gb.y));
                    *(u32x2*)(mg + off) = o; }
            }
        }
    }
    xcd_barrier(xbar);
    for (int rep = 0; rep < REPS(6); ++rep) {
        if (rep) xcd_barrier(xbar);
        pg8::Gemm g{(const bf16_t*)(ws + WS_S1), (const bf16_t*)(ws + WS_WO), MP, 1024, 1024}; pg8::StaticOrder S; S.init(MP, 1024, G, bid);
        EpiRes<false> E{P.in[0], xmid, mod, 2048}; pg8::gemm_phase<EpiRes<false>>(lds, g, S, E);
        {
            const int t2 = opaque_tid(), lane = t2 & 63, wave = t2 >> 6, fr = lane & 15, fq = lane >> 4;
            for (int t = bid; t < 256; t += G) {
                const int m0 = MP + (t >> 5) * 128, n0 = (t & 31) * 32;
                f32x4 a1[2] = {{0.f, 0.f, 0.f, 0.f}, {0.f, 0.f, 0.f, 0.f}};
                small_gemm<1024>(lds, (const bf16_t*)(ws + WS_S1), (const bf16_t*)(ws + WS_WO), m0, n0, t2, a1);
                const int r = m0 + wave * 16 + fr;
#pragma unroll
                for (int ct = 0; ct < 2; ++ct) { const int c = n0 + ct * 16 + 4 * fq;
                    const f32x4 xv = *(const f32x4*)(P.in[1] + (size_t)(r - MP) * 1024 + c), gv = *(const f32x4*)(mod + (size_t)batch_of_row(r) * NMOD + 2048 + c);
                    const f32x4 o = xv + gv * a1[ct]; u32x2 w; w.x = pk_bf16(o[0], o[1]); w.y = pk_bf16(o[2], o[3]);
                    *(u32x2*)(xmid + (size_t)r * 1024 + c) = w; }
            }
        }
    }
    xcd_barrier(xbar);
    phase_norm<1>(nullptr, nullptr, xmid, P.in[26], mod, 3072, 4096, (bf16_t*)(ws + WS_S0), nullptr);
    xcd_barrier(xbar);
    for (int rep = 0; rep < REPS(8); ++rep) {
        if (rep) xcd_barrier(xbar);
        pg8::Gemm g{(const bf16_t*)(ws + WS_S0), (const bf16_t*)(ws + WS_WUP), MT, 6144, 1024}; pg8::StaticOrder S; S.init(MT, 6144, G, bid);
        EpiUp E{(bf16_t*)(ws + WS_ACT), P.in[28], P.in[29], P.out + O_Y  , (float*)(ws + WS_UPA), (float*)(ws + WS_UPB), P.out, lds + LDS_STAGE};
        pg8::gemm_phase<EpiUp>(lds, g, S, E);
    }
    xcd_barrier(xbar);
    {
        const float* upa = (const float*)(ws + WS_UPA); const float* upb = (const float*)(ws + WS_UPB);
        const float* wdw = P.in[28]; const float* bdw = P.in[29];
        bf16_t* act = (bf16_t*)(ws + WS_ACT);
        for (int e = bid * NTHREADS + opaque_tid(); e < 56 * 2 * 3072; e += G * NTHREADS) {
            const int c = e % 3072, rr = (e / 3072) & 1, ti = e / 6144, pm = (ti / 7) * 8 + 1 + ti % 7;
            float cv[2];
#pragma unroll
            for (int bj = 0; bj < 2; ++bj) { const int col = bj * 3072 + c;
                const float a0 = upa[((size_t)pm * 2 + 0) * 6144 + col], a1 = upa[((size_t)pm * 2 + 1) * 6144 + col];
                const float b0 = upb[((size_t)(pm - 1) * 2 + 0) * 6144 + col], b1 = upb[((size_t)(pm - 1) * 2 + 1) * 6144 + col];
                const float cur = rr ? a1 : a0, p1 = rr ? a0 : b1, p2 = rr ? b1 : b0;
                cv[bj] = wdw[2 * 6144 + col] * cur + wdw[6144 + col] * p1 + wdw[col] * p2 + bdw[col]; }
            act[((size_t)pm * 256 + rr) * 3072 + c] = (bf16_t)(pk_bf16(gelu_tanh(cv[0]) * cv[1], 0.f) & 0xffffu);
        }
    }
    {
        const float* ups = P.out + O_Y; const float* stf = P.in[5];
        const float* wdw = P.in[28]; const float* bdw = P.in[29];
        bf16_t* act = (bf16_t*)(ws + WS_ACT);
        for (int e = bid * NTHREADS + opaque_tid(); e < MS * 768; e += G * NTHREADS) {
            const int c = (e % 768) * 4, s = e / 768, sb = s >> 3, t = s & 7;
            f32x4 cv[2];
#pragma unroll
            for (int bj = 0; bj < 2; ++bj) { const int col = bj * 3072 + c;
                const f32x4 cur = *(const f32x4*)(ups + (size_t)s * 6144 + col);
                const f32x4 p1 = *(const f32x4*)(t >= 1 ? ups + (size_t)(s - 1) * 6144 + col : stf + ((size_t)sb * 2 + 1) * 6144 + col);
                const f32x4 p2 = *(const f32x4*)(t >= 2 ? ups + (size_t)(s - 2) * 6144 + col : stf + ((size_t)sb * 2 + t) * 6144 + col);
                cv[bj] = *(const f32x4*)(wdw + 2 * 6144 + col) * cur + *(const f32x4*)(wdw + 6144 + col) * p1 + *(const f32x4*)(wdw + col) * p2 + *(const f32x4*)(bdw + col);
                if (t >= 6) *(f32x4*)(P.out + O_FFN_S + ((size_t)sb * 2 + t - 6) * 6144 + col) = cur; }
            u32x2 o; o.x = pk_bf16(gelu_tanh(cv[0][0]) * cv[1][0], gelu_tanh(cv[0][1]) * cv[1][1]); o.y = pk_bf16(gelu_tanh(cv[0][2]) * cv[1][2], gelu_tanh(cv[0][3]) * cv[1][3]);
            *(u32x2*)(act + ((size_t)MP + s) * 3072 + c) = o;
        }
    }
    xcd_barrier(xbar);
    {
        pg8::Gemm g{(const bf16_t*)(ws + WS_ACT), (const bf16_t*)(ws + WS_WDN), MP, 1024, 3072}; pg8::StaticOrder S; S.init(MP, 1024, G, bid);
        EpiRes<true> E{nullptr, xmid, mod, 5120}; pg8::gemm_phase<EpiRes<true>>(lds, g, S, E);
        {
            const int t2 = opaque_tid(), lane = t2 & 63, wave = t2 >> 6, fr = lane & 15, fq = lane >> 4;
            for (int t = bid; t < 256; t += G) {
                const int m0 = MP + (t >> 5) * 128, n0 = (t & 31) * 32;
                f32x4 a1[2] = {{0.f, 0.f, 0.f, 0.f}, {0.f, 0.f, 0.f, 0.f}};
                small_gemm<3072>(lds, (const bf16_t*)(ws + WS_ACT), (const bf16_t*)(ws + WS_WDN), m0, n0, t2, a1);
                const int r = m0 + wave * 16 + fr;
#pragma unroll
                for (int ct = 0; ct < 2; ++ct) { const int c = n0 + ct * 16 + 4 * fq;
                    bf16_t* xp = xmid + (size_t)r * 1024 + c;
                    const u32x2 xw = *(const u32x2*)xp; const f32x4 xv = {bf_lo(xw.x), bf_hi(xw.x), bf_lo(xw.y), bf_hi(xw.y)}, gv = *(const f32x4*)(mod + (size_t)batch_of_row(r) * NMOD + 5120 + c);
                    const f32x4 o = xv + gv * a1[ct]; u32x2 w; w.x = pk_bf16(o[0], o[1]); w.y = pk_bf16(o[2], o[3]);
                    *(u32x2*)xp = w; }
            }
        }
    }
    xcd_barrier(xbar);
    phase_norm<2>(nullptr, nullptr, xmid, P.in[31], nullptr, 0, 0, nullptr, P.out + O_Y);
}

extern "C" void kernel_launch(void* const* d_in, const int* in_sizes, int n_in, void* d_out, int out_size, void* d_ws, size_t ws_size, hipStream_t stream) {
    static int grid_blocks = 0;
    if (grid_blocks == 0) {
        if (n_in != 32 || (size_t)out_size != O_END || ws_size < WS_NEED) { fprintf(stderr, "kernel_launch: unexpected shapes: n_in %d out %d ws %zu (need %zu)\n", n_in, out_size, ws_size, (size_t)WS_NEED); grid_blocks = -1; return; }
        int dev = 0, cus = 0, per_cu = 0;
        hipGetDevice(&dev);
        hipDeviceGetAttribute(&cus, hipDeviceAttributeMultiprocessorCount, dev);
        if (hipFuncSetAttribute((const void*)fwd_megakernel, hipFuncAttributeMaxDynamicSharedMemorySize, LDS_BYTES) != hipSuccess) { fprintf(stderr, "kernel_launch: hipFuncSetAttribute failed\n"); grid_blocks = -1; return; }
        if (hipOccupancyMaxActiveBlocksPerMultiprocessor(&per_cu, (const void*)fwd_megakernel, NTHREADS, LDS_BYTES) != hipSuccess || per_cu < 1) { fprintf(stderr, "kernel_launch: occupancy query gave %d\n", per_cu); per_cu = 1; (void)hipGetLastError(); }
        grid_blocks = cus;
    }
    if (grid_blocks < 0) return;
    Params p{};
    for (int i = 0; i < 32; ++i) p.in[i] = (const float*)d_in[i];
    p.out = (float*)d_out; p.ws = (unsigned char*)d_ws;
    if (hipMemsetAsync((char*)d_ws + WS_BAR, 0, WS_BAR_BYTES, stream) != hipSuccess) { fprintf(stderr, "kernel_launch: memset of barrier words failed\n"); return; }
    void* args[] = {&p};
    hipError_t e = hipLaunchCooperativeKernel((const void*)fwd_megakernel, dim3(grid_blocks), dim3(NTHREADS), args, LDS_BYTES, stream);
    if (e != hipSuccess) fprintf(stderr, "cooperative launch failed: %s (grid %d)\n", hipGetErrorString(e), grid_blocks);
}
```

```cpp
#include <hip/hip_runtime.h>
#include <hip/hip_cooperative_groups.h>
#include <cstdio>
namespace cg = cooperative_groups;

#define LAS __attribute__((address_space(3)))
typedef unsigned short bf16_t;
typedef short bf16x8 __attribute__((ext_vector_type(8)));
typedef float f32x4 __attribute__((ext_vector_type(4)));
typedef float f32x2 __attribute__((ext_vector_type(2)));
typedef unsigned u32x4 __attribute__((ext_vector_type(4)));
typedef unsigned u32x2 __attribute__((ext_vector_type(2)));

constexpr int MP = 16384, MS = 1024, MT = MP + MS;
constexpr int DM = 1024, DC = 1024, DR = 1280, DFF = 3072, DIN = 6656, NMOD = 6144, NBATCH = 136;
constexpr int SEQ = 2048, DSEQ = 8;
constexpr float EPS = 1e-6f;
constexpr int NTHREADS = 512, NWAVES = 8;
#ifndef REP_PHASE
#define REP_PHASE -1
#endif
#define REPS(k) ((REP_PHASE == (k)) ? 2 : 1)

constexpr size_t A1K = (size_t)MT * 1024 * 2, A1280 = (size_t)MT * 1280 * 2;
constexpr size_t WS_WIN = 0;
constexpr size_t WS_WCA = WS_WIN + (size_t)DIN * 1024 * 2;
constexpr size_t WS_WRB = WS_WCA + (size_t)1024 * 1024 * 2;
constexpr size_t WS_WO  = WS_WRB + (size_t)1024 * 1280 * 2;
constexpr size_t WS_WUP = WS_WO + (size_t)1024 * 1024 * 2;
constexpr size_t WS_WDN = WS_WUP + (size_t)6144 * 1024 * 2;
constexpr size_t WS_WRG = WS_WDN + (size_t)1024 * 3072 * 2;
constexpr size_t WS_WIG = WS_WRG + (size_t)8 * 160 * 160 * 2;
constexpr size_t WS_MOD = WS_WIG + (size_t)8 * 160 * 160 * 2;
constexpr size_t WS_HL  = WS_MOD + (size_t)NBATCH * NMOD * 4;
constexpr size_t WS_PL  = WS_HL + (size_t)8 * 32 * 1280 * 4;
constexpr size_t WS_SP8 = WS_PL + (size_t)8 * 32 * 1280 * 4;
constexpr size_t WS_BAR = ((WS_SP8 + (size_t)1280 * 4 + 255) / 256) * 256;
constexpr size_t WS_BAR_BYTES = 3456 * 4;
constexpr size_t WS_SCH = ((WS_BAR + WS_BAR_BYTES + 255) / 256) * 256;
constexpr size_t WS_SCL = WS_SCH + (size_t)144 * 1024 * 2;
constexpr size_t WS_S0  = ((WS_SCL + (size_t)144 * 1024 * 2 + 4095) / 4096) * 4096;
constexpr size_t WS_S3  = WS_S0 + A1K;
constexpr size_t WS_S1  = WS_S3 + A1280;
constexpr size_t WS_S2  = WS_S1 + A1K;
constexpr size_t WS_S4  = WS_S2 + A1280;
constexpr size_t WS_ACT = WS_S1;
constexpr size_t WS_UPA = WS_ACT + (size_t)MT * 3072 * 2;
constexpr size_t WS_UPB = WS_UPA + (size_t)68 * 2 * 6144 * 4;
constexpr size_t WS_END0 = WS_S4 + A1280;
constexpr size_t WS_END1 = WS_UPB + (size_t)68 * 2 * 6144 * 4;
static_assert(WS_END1 <= WS_END0, "act + side buffers must fit in S1..S4");
constexpr size_t WS_UPS = WS_S3;
static_assert((size_t)MS * 6144 * 4 <= A1280, "ups fits S3");
constexpr size_t WS_NEED = WS_END0;
static_assert(WS_NEED <= (size_t)256 * 1024 * 1024, "workspace budget");

constexpr size_t O_Y = 0;
constexpr size_t O_CONF_P = (size_t)MT * 1024;
constexpr size_t O_RCONV_P = O_CONF_P + (size_t)8 * 30 * 1024;
constexpr size_t O_H_P = O_RCONV_P + (size_t)8 * 3 * 1280;
constexpr size_t O_FFN_P = O_H_P + (size_t)8 * 1280;
constexpr size_t O_CONF_S = O_FFN_P + (size_t)8 * 2 * 6144;
constexpr size_t O_RCONV_S = O_CONF_S + (size_t)128 * 30 * 1024;
constexpr size_t O_H_S = O_RCONV_S + (size_t)128 * 3 * 1280;
constexpr size_t O_FFN_S = O_H_S + (size_t)128 * 1280;
constexpr size_t O_END = O_FFN_S + (size_t)128 * 2 * 6144;

constexpr int LDS_STAGE = 131072, LDS_EXCH = 8192, LDS_CW = LDS_STAGE + LDS_EXCH, LDS_BARW = LDS_CW + 4096, LDS_BYTES = LDS_BARW + 16;

struct Params { const float* in[32]; float* out; unsigned char* ws; };

typedef __bf16 bf16x2_t __attribute__((ext_vector_type(2)));
__device__ __forceinline__ unsigned pk_bf16(float lo, float hi) { const f32x2 v = {lo, hi}; const bf16x2_t b = __builtin_convertvector(v, bf16x2_t); return __builtin_bit_cast(unsigned, b); }
__device__ __forceinline__ float bf_lo(unsigned w) { return __uint_as_float(w << 16); }
__device__ __forceinline__ float bf_hi(unsigned w) { return __uint_as_float(w & 0xffff0000u); }
__device__ __forceinline__ float sigmoidf_(float x) { return __builtin_amdgcn_rcpf(1.0f + __expf(-x)); }
__device__ __forceinline__ float siluf_(float x) { return x * sigmoidf_(x); }
__device__ __forceinline__ float gelu_tanh(float x) { const float u = 1.5957691216057308f * (x + 0.044715f * x * x * x); return x * sigmoidf_(u); }
__device__ __forceinline__ f32x2 sigmoid2(f32x2 x) { const f32x2 t = x * (-1.4426950408889634f); f32x2 e; e.x = __builtin_amdgcn_exp2f(t.x); e.y = __builtin_amdgcn_exp2f(t.y);
    const f32x2 d = e + 1.0f; f32x2 r; r.x = __builtin_amdgcn_rcpf(d.x); r.y = __builtin_amdgcn_rcpf(d.y); return r; }
__device__ __forceinline__ f32x2 gelu2(f32x2 x) {
    const f32x2 t = x * ((x * x) * (-0.10294324f) + (-2.3022082f)); f32x2 e; e.x = __builtin_amdgcn_exp2f(t.x); e.y = __builtin_amdgcn_exp2f(t.y);
    const f32x2 d = e + 1.0f; f32x2 r; r.x = __builtin_amdgcn_rcpf(d.x); r.y = __builtin_amdgcn_rcpf(d.y); return x * r; }
__device__ __forceinline__ float wave_sum(float v) {
#pragma unroll
    for (int o = 1; o < 64; o <<= 1) v += __shfl_xor(v, o);
    return v;
}
__device__ __forceinline__ int batch_of_row(int r) { return r < MP ? (r >> 11) : 8 + ((r - MP) >> 3); }
__device__ __forceinline__ int opaque_tid() { int t = threadIdx.x; asm volatile("" : "+v"(t)); return t; }
#define LDS_FENCE() asm volatile("s_waitcnt lgkmcnt(0)" ::: "memory")

namespace pg8 {
constexpr int BM = 256, BK = 64, HALF = 128, HTB = HALF * BK * 2, STAGE_BYTES = 8 * HTB, NXCD = 8, WGM = 8;
__host__ __device__ __forceinline__ int lds_byte(int r, int c) { const int st = (r >> 4) * 2 + (c >> 5), rr = r & 15, cc = c & 31, ob = rr * 64 + cc * 2; return st * 1024 + (ob ^ (((ob >> 9) & 1) << 5)); }
__host__ __device__ __forceinline__ void stage_rc(int b, int& R, int& C) { const int st = b / 1024, sb = b % 1024, swz = sb ^ (((sb >> 9) & 1) << 5); R = (st >> 1) * 16 + swz / 64; C = (st & 1) * 32 + (swz % 64) / 2; }
__host__ __device__ __forceinline__ int perm32(int rho) { const int n = rho >> 4, i = rho & 15; return 8 * (i >> 2) + 4 * n + (i & 3); }
struct Unit { int pm, pn; };
struct Gemm { const bf16_t* A; const bf16_t* Bt; int M, N, K; };
struct StaticOrder {
    int nM, nN, nwg, G, c;
    __device__ void init(int M, int N, int G_, int c_) { nM = M / BM; nN = N / BM; nwg = nM * nN; G = G_; c = c_; }
    __device__ bool next(int i, Unit& u) const {
        const long L = (long)i * G + c; if (L >= nwg) return false;
        int wgid = (int)L; { const int q = nwg / NXCD, r = nwg % NXCD, xcd = wgid % NXCD, off = wgid / NXCD; wgid = (xcd < r ? xcd * (q + 1) : r * (q + 1) + (xcd - r) * q) + off; }
        const int nig = WGM * nN, gid = wgid / nig, fm = gid * WGM, gsz = (nM - fm) < WGM ? (nM - fm) : WGM;
        u.pm = fm + ((wgid % nig) % gsz); u.pn = (wgid % nig) / gsz; return true;
    }
};

template <class Epi>
__device__ __forceinline__ void gemm_phase(LAS unsigned char* lds, const Gemm g, const StaticOrder& S, const Epi& E) {
    int tid_ = threadIdx.x; asm volatile("" : "+v"(tid_));
    const int tid = tid_, wid = __builtin_amdgcn_readfirstlane(tid >> 6), lane = tid & 63, wr = wid >> 2, wc = wid & 3, fr = lane & 15, fq = lane >> 4;
    const int K = g.K, nt = K / BK;
    unsigned voffA[2], voffB[2];
#pragma unroll
    for (int i = 0; i < 2; ++i) { int R, C; stage_rc(tid * 16 + i * 8192, R, C); const int Rb = Epi::PERM ? ((R & ~31) + perm32(R & 31)) : R;
        voffA[i] = (unsigned)(R * K + C) * 2u; voffB[i] = (unsigned)(Rb * K + C) * 2u; }
    const size_t kstep = (size_t)(BK * 2);
    const size_t hstep = (size_t)HALF * K * 2;
    const size_t tstep = 2 * hstep;
    const unsigned ldsw = (unsigned)wid * 1024u;
    const int aoff = lds_byte(wr * 64 + fr, fq * 8), boff = lds_byte(wc * 32 + fr, fq * 8);
#define PG8_SA(b, h) (((b) * 2 + (h)) * HTB)
#define PG8_SB(b, h) ((4 + (b) * 2 + (h)) * HTB)
#define PG8_STAGE(bufoff, gbase, voff) do { _Pragma("unroll") for (int _i = 0; _i < 2; ++_i) \
        __builtin_amdgcn_global_load_lds((const unsigned*)((const char*)(gbase) + (voff)[_i]), (LAS unsigned*)(lds + (bufoff) + ldsw + _i * 8192), 16, 0, 0); } while (0)
#define PG8_LDA(dst, b, h) do { _Pragma("unroll") for (int m = 0; m < 4; ++m) _Pragma("unroll") for (int k = 0; k < 2; ++k) dst[m][k] = *(const LAS bf16x8*)(lds + PG8_SA(b, h) + aoff + m * 2048 + k * 1024); } while (0)
#define PG8_LDB(dst, b, h) do { _Pragma("unroll") for (int n = 0; n < 2; ++n) _Pragma("unroll") for (int k = 0; k < 2; ++k) dst[n][k] = *(const LAS bf16x8*)(lds + PG8_SB(b, h) + boff + n * 2048 + k * 1024); } while (0)
#define PG8_MMA(ai, bj, At, Bt) do { __builtin_amdgcn_s_setprio(1); _Pragma("unroll") for (int m = 0; m < 4; ++m) _Pragma("unroll") for (int n = 0; n < 2; ++n) _Pragma("unroll") for (int k = 0; k < 2; ++k) \
        acc[ai][bj][m][n] = __builtin_amdgcn_mfma_f32_16x16x32_bf16(Bt[n][k], At[m][k], acc[ai][bj][m][n], 0, 0, 0); __builtin_amdgcn_s_setprio(0); } while (0)
#define PG8_WAIT_V(n) asm volatile("s_waitcnt vmcnt(" #n ")" ::: "memory")
#define PG8_WAIT_L(n) asm volatile("s_waitcnt lgkmcnt(" #n ")" ::: "memory")
#define PG8_BAR __builtin_amdgcn_s_barrier()
#define PG8_SCHED __builtin_amdgcn_sched_barrier(0)
    Unit cur, nxt; int ui = 0;
    if (!S.next(0, cur)) return;
    f32x4 acc[2][2][4][2];
#pragma unroll
    for (int a = 0; a < 2; ++a)
#pragma unroll
        for (int b = 0; b < 2; ++b)
#pragma unroll
            for (int m = 0; m < 4; ++m)
#pragma unroll
                for (int n = 0; n < 2; ++n) acc[a][b][m][n] = (f32x4){0.f, 0.f, 0.f, 0.f};
    bf16x8 At[4][2], B0[2][2], B1[2][2];
    const char* cA = (const char*)g.A + (size_t)cur.pm * tstep; const char* cB = (const char*)g.Bt + (size_t)cur.pn * tstep;
    PG8_STAGE(PG8_SB(0, 0), cB, voffB); PG8_STAGE(PG8_SA(0, 0), cA, voffA); PG8_STAGE(PG8_SB(0, 1), cB + hstep, voffB); PG8_STAGE(PG8_SA(0, 1), cA + hstep, voffA);
    if (wr == 1) PG8_BAR;
    PG8_WAIT_V(4); PG8_BAR;
    PG8_STAGE(PG8_SB(1, 0), cB + kstep, voffB); PG8_STAGE(PG8_SA(1, 0), cA + kstep, voffA); PG8_STAGE(PG8_SB(1, 1), cB + hstep + kstep, voffB);
    PG8_WAIT_V(6); PG8_BAR;
    for (;;) {
        const bool has_next = S.next(ui + 1, nxt);
        const char* nA = has_next ? (const char*)g.A + (size_t)nxt.pm * tstep : cA; const char* nB = has_next ? (const char*)g.Bt + (size_t)nxt.pn * tstep : cB;
        for (int t = 0; t < nt; t += 2) {
            const bool last = (t == nt - 2);
            const char* a1 = cA + (size_t)(t + 1) * kstep;
            const char* a2 = last ? nA : cA + (size_t)(t + 2) * kstep; const char* b2 = last ? nB : cB + (size_t)(t + 2) * kstep;
            const char* a3 = a2 + kstep; const char* b3 = b2 + kstep;
            PG8_LDB(B0, 0, 0); PG8_SCHED; PG8_LDA(At, 0, 0); PG8_STAGE(PG8_SA(1, 1), a1 + hstep, voffA);
            PG8_WAIT_L(8); PG8_BAR; PG8_WAIT_L(0); PG8_MMA(0, 0, At, B0); PG8_BAR; PG8_SCHED;
            PG8_LDB(B1, 0, 1); PG8_STAGE(PG8_SB(0, 0), b2, voffB);
            PG8_BAR; PG8_WAIT_L(0); PG8_MMA(0, 1, At, B1); PG8_BAR;
            PG8_LDA(At, 0, 1); PG8_STAGE(PG8_SA(0, 0), a2, voffA);
            PG8_BAR; PG8_WAIT_L(0); PG8_MMA(1, 0, At, B0); PG8_BAR; PG8_SCHED;
            PG8_STAGE(PG8_SB(0, 1), b2 + hstep, voffB);
            PG8_WAIT_V(6); PG8_BAR; PG8_MMA(1, 1, At, B1); PG8_BAR;
            PG8_LDB(B0, 1, 0); PG8_SCHED; PG8_LDA(At, 1, 0); PG8_STAGE(PG8_SA(0, 1), a2 + hstep, voffA);
            PG8_WAIT_L(8); PG8_BAR; PG8_WAIT_L(0); PG8_MMA(0, 0, At, B0); PG8_BAR; PG8_SCHED;
            PG8_LDB(B1, 1, 1); PG8_STAGE(PG8_SB(1, 0), b3, voffB);
            PG8_BAR; PG8_WAIT_L(0); PG8_MMA(0, 1, At, B1); PG8_BAR;
            PG8_LDA(At, 1, 1); PG8_STAGE(PG8_SA(1, 0), a3, voffA);
            PG8_BAR; PG8_WAIT_L(0); PG8_MMA(1, 0, At, B0); PG8_BAR; PG8_SCHED;
            PG8_STAGE(PG8_SB(1, 1), b3 + hstep, voffB);
            PG8_WAIT_V(6); PG8_BAR; PG8_MMA(1, 1, At, B1); PG8_BAR;
        }
        { int e_fr = fr, e_fq = fq, e_wr = wr, e_wc = wc; asm volatile("" : "+v"(e_fr), "+v"(e_fq), "+s"(e_wr), "+s"(e_wc));
          E(acc, cur, e_wr, e_wc, e_fr, e_fq); }
        if (!has_next) break;
#pragma unroll
        for (int a = 0; a < 2; ++a)
#pragma unroll
            for (int b = 0; b < 2; ++b)
#pragma unroll
                for (int m = 0; m < 4; ++m)
#pragma unroll
                    for (int n = 0; n < 2; ++n) acc[a][b][m][n] = (f32x4){0.f, 0.f, 0.f, 0.f};
        cur = nxt; cA = nA; cB = nB; ++ui;
    }
    PG8_WAIT_V(0);
    if (wr == 0) PG8_BAR;
    PG8_BAR;
#undef PG8_SA
#undef PG8_SB
#undef PG8_STAGE
#undef PG8_LDA
#undef PG8_LDB
#undef PG8_MMA
#undef PG8_WAIT_V
#undef PG8_WAIT_L
#undef PG8_SCHED
}
}
using pg8::Unit;

typedef const f32x4 (&AccRef)[2][2][4][2];

struct EpiIn {
    static constexpr bool PERM = true;
    bf16_t *uglu, *rnnx, *gg, *sga, *sgb; float* out;
    __device__ __forceinline__ void operator()(AccRef acc, const Unit& u, int wr, int wc, int fr, int fq) const {
        const int row0 = u.pm * 256 + wr * 64 + fr, cl = wc * 32 + 8 * fq;
        if (u.pn < 8) {
            const int col = u.pn * 128 + cl;
#pragma unroll
            for (int ai = 0; ai < 2; ++ai)
#pragma unroll
                for (int m = 0; m < 4; ++m) {
                    const int r = row0 + ai * 128 + m * 16;
                    f32x4 o[2];
#pragma unroll
                    for (int n = 0; n < 2; ++n)
#pragma unroll
                        for (int jp = 0; jp < 2; ++jp) { const f32x2 vv = {acc[ai][0][m][n][2 * jp], acc[ai][0][m][n][2 * jp + 1]}, gg2 = {acc[ai][1][m][n][2 * jp], acc[ai][1][m][n][2 * jp + 1]};
                            const f32x2 r = vv * sigmoid2(gg2); o[n][2 * jp] = r.x; o[n][2 * jp + 1] = r.y; }
                    u32x4 w; w.x = pk_bf16(o[0][0], o[0][1]); w.y = pk_bf16(o[0][2], o[0][3]); w.z = pk_bf16(o[1][0], o[1][1]); w.w = pk_bf16(o[1][2], o[1][3]);
                    *(u32x4*)(uglu + (size_t)r * 1024 + col) = w;
                    float* so = nullptr;
                    if (r < MP) { const int t = r & 2047; if (t >= 2018) so = out + O_CONF_P + ((size_t)(r >> 11) * 30 + (t - 2018)) * 1024 + col; }
                    else { const int s = r - MP; so = out + O_CONF_S + ((size_t)(s >> 3) * 30 + 22 + (s & 7)) * 1024 + col; }
                    if (so) { *(f32x4*)so = o[0]; *(f32x4*)(so + 4) = o[1]; }
                }
        } else if (u.pn < 13) {
#pragma unroll
            for (int ai = 0; ai < 2; ++ai)
#pragma unroll
                for (int m = 0; m < 4; ++m) {
                    const int r = row0 + ai * 128 + m * 16;
                    float* so = nullptr;
                    if (r < MP) { const int t = r & 2047; if (t >= 2045) so = out + O_RCONV_P + ((size_t)(r >> 11) * 3 + (t - 2045)) * 1280; }
                    else { const int s = r - MP; if ((s & 7) >= 5) so = out + O_RCONV_S + ((size_t)(s >> 3) * 3 + (s & 7) - 5) * 1280; }
#pragma unroll
                    for (int bj = 0; bj < 2; ++bj) {
                        const int col = (u.pn - 8) * 256 + bj * 128 + cl;
                        const f32x4 v0 = acc[ai][bj][m][0], v1 = acc[ai][bj][m][1];
                        u32x4 w; w.x = pk_bf16(v0[0], v0[1]); w.y = pk_bf16(v0[2], v0[3]); w.z = pk_bf16(v1[0], v1[1]); w.w = pk_bf16(v1[2], v1[3]);
                        *(u32x4*)(rnnx + (size_t)r * 1280 + col) = w;
                        if (so) { *(f32x4*)(so + col) = v0; *(f32x4*)(so + col + 4) = v1; }
                    }
                }
        } else if (u.pn < 18) { act_store<true>(acc, gg, 1280, (u.pn - 13) * 256 + cl, row0); }
        else if (u.pn < 22) { act_store<false>(acc, sga, 1024, (u.pn - 18) * 256 + cl, row0); }
        else { act_store<false>(acc, sgb, 1024, (u.pn - 22) * 256 + cl, row0); }
    }
    template <bool ISG> __device__ __forceinline__ void act_store(AccRef acc, bf16_t* dst, int ld, int c0, int row0) const {
#pragma unroll
        for (int ai = 0; ai < 2; ++ai)
#pragma unroll
            for (int m = 0; m < 4; ++m) {
                const int r = row0 + ai * 128 + m * 16;
#pragma unroll
                for (int bj = 0; bj < 2; ++bj) {
                    f32x4 v0 = acc[ai][bj][m][0], v1 = acc[ai][bj][m][1];
#pragma unroll
                    for (int jp = 0; jp < 2; ++jp) { const f32x2 a = {v0[2 * jp], v0[2 * jp + 1]}, b = {v1[2 * jp], v1[2 * jp + 1]};
                        const f32x2 ra = ISG ? gelu2(a) : sigmoid2(a), rb = ISG ? gelu2(b) : sigmoid2(b);
                        v0[2 * jp] = ra.x; v0[2 * jp + 1] = ra.y; v1[2 * jp] = rb.x; v1[2 * jp + 1] = rb.y; }
                    u32x4 w; w.x = pk_bf16(v0[0], v0[1]); w.y = pk_bf16(v0[2], v0[3]); w.z = pk_bf16(v1[0], v1[1]); w.w = pk_bf16(v1[2], v1[3]);
                    *(u32x4*)(dst + (size_t)r * ld + c0 + bj * 128) = w;
                }
            }
    }
};

template <int MODE> struct EpiMerge {
    static constexpr bool PERM = true;
    bf16_t* T; const bf16_t* gate;
    __device__ __forceinline__ void operator()(AccRef acc, const Unit& u, int wr, int wc, int fr, int fq) const {
        const int row0 = u.pm * 256 + wr * 64 + fr, col0 = u.pn * 256 + wc * 32 + 8 * fq;
#pragma unroll
        for (int ai = 0; ai < 2; ++ai)
#pragma unroll
            for (int m = 0; m < 4; ++m) {
                const size_t rb = (size_t)(row0 + ai * 128 + m * 16) * 1024;
#pragma unroll
                for (int bj = 0; bj < 2; ++bj) {
                    const size_t off = rb + col0 + bj * 128;
                    const u32x4 gw = *(const u32x4*)(gate + off);
                    const f32x4 v0 = acc[ai][bj][m][0], v1 = acc[ai][bj][m][1];
                    float o[8];
                    o[0] = v0[0] * bf_lo(gw.x); o[1] = v0[1] * bf_hi(gw.x); o[2] = v0[2] * bf_lo(gw.y); o[3] = v0[3] * bf_hi(gw.y);
                    o[4] = v1[0] * bf_lo(gw.z); o[5] = v1[1] * bf_hi(gw.z); o[6] = v1[2] * bf_lo(gw.w); o[7] = v1[3] * bf_hi(gw.w);
                    if (MODE == 1) { const u32x4 tw = *(const u32x4*)(T + off);
                        o[0] += bf_lo(tw.x); o[1] += bf_hi(tw.x); o[2] += bf_lo(tw.y); o[3] += bf_hi(tw.y); o[4] += bf_lo(tw.z); o[5] += bf_hi(tw.z); o[6] += bf_lo(tw.w); o[7] += bf_hi(tw.w); }
                    u32x4 w; w.x = pk_bf16(o[0], o[1]); w.y = pk_bf16(o[2], o[3]); w.z = pk_bf16(o[4], o[5]); w.w = pk_bf16(o[6], o[7]);
                    *(u32x4*)(T + off) = w;
                }
            }
    }
};

template <bool INPLACE> struct EpiRes {
    static constexpr bool PERM = true;
    const float* xp; bf16_t* xb; const float* mod; int goff;
    __device__ __forceinline__ void operator()(AccRef acc, const Unit& u, int wr, int wc, int fr, int fq) const {
        const int row0 = u.pm * 256 + wr * 64 + fr, col0 = u.pn * 256 + wc * 32 + 8 * fq;
#pragma unroll
        for (int ai = 0; ai < 2; ++ai)
#pragma unroll
            for (int m = 0; m < 4; ++m) {
                const int r = row0 + ai * 128 + m * 16;
                const float* gp = mod + (size_t)(r >> 11) * NMOD + goff;
#pragma unroll
                for (int bj = 0; bj < 2; ++bj) {
                    const int c = col0 + bj * 128;
                    const f32x4 g0 = *(const f32x4*)(gp + c), g1 = *(const f32x4*)(gp + c + 4);
                    f32x4 x0, x1;
                    if (!INPLACE) { x0 = *(const f32x4*)(xp + (size_t)r * 1024 + c); x1 = *(const f32x4*)(xp + (size_t)r * 1024 + c + 4); }
                    else { const u32x4 w = *(const u32x4*)(xb + (size_t)r * 1024 + c); x0 = (f32x4){bf_lo(w.x), bf_hi(w.x), bf_lo(w.y), bf_hi(w.y)}; x1 = (f32x4){bf_lo(w.z), bf_hi(w.z), bf_lo(w.w), bf_hi(w.w)}; }
                    x0 = x0 + g0 * acc[ai][bj][m][0]; x1 = x1 + g1 * acc[ai][bj][m][1];
                    u32x4 o; o.x = pk_bf16(x0[0], x0[1]); o.y = pk_bf16(x0[2], x0[3]); o.z = pk_bf16(x1[0], x1[1]); o.w = pk_bf16(x1[2], x1[3]);
                    *(u32x4*)(xb + (size_t)r * 1024 + c) = o;
                }
            }
    }
};

struct EpiUp {
    static constexpr bool PERM = true;
    bf16_t* act; const float* wdw; const float* bdw; float* ups; float* upa; float* upb; float* out; LAS unsigned char* exch;
    template <int CTRL> static __device__ __forceinline__ float dpp_keep(float old, float src) {
        return __builtin_bit_cast(float, __builtin_amdgcn_update_dpp(__builtin_bit_cast(int, old), __builtin_bit_cast(int, src), CTRL, 0xf, 0xf, false)); }
    __device__ __forceinline__ void conv_prompt(AccRef acc, const Unit& u, int wr, int wc, int fr, int fq) const {
        const int cl = wc * 32 + 8 * fq;
#pragma unroll
        for (int ai = 0; ai < 2; ++ai) {
            const int slab = 2 * ai + wr;
            const int rowb = u.pm * 256 + ai * 128 + wr * 64 + fr;
#pragma unroll
            for (int n = 0; n < 2; ++n)
#pragma unroll
            for (int jp = 0; jp < 2; ++jp) {
                float gq[4][2];
                int clx = cl;
#pragma unroll
                for (int bj = 0; bj < 2; ++bj) {
                    asm volatile("" : "+v"(clx));
                    const int col = bj * 3072 + u.pn * 128 + clx + 4 * n + 2 * jp;
                    const LAS float* cwp = (const LAS float*)(exch + LDS_EXCH) + bj * 128 + clx + 4 * n + 2 * jp;
                    const f32x2 W0 = *(const LAS f32x2*)cwp, W1 = *(const LAS f32x2*)(cwp + 256), W2 = *(const LAS f32x2*)(cwp + 512), BB = *(const LAS f32x2*)(cwp + 768);
                    f32x2 X1 = {0.f, 0.f}, X2 = {0.f, 0.f};
                    if (slab > 0) {
                        X1 = *(const LAS f32x2*)(exch + (size_t)(((((slab - 1) * 2 + 1) * 2 + bj) * 128 + clx + 4 * n + 2 * jp) * 4));
                        X2 = *(const LAS f32x2*)(exch + (size_t)(((((slab - 1) * 2 + 0) * 2 + bj) * 128 + clx + 4 * n + 2 * jp) * 4));
                    }
#pragma unroll
                    for (int jj = 0; jj < 2; ++jj) {
#pragma unroll
                        for (int m = 0; m < 4; ++m) {
                            const float cur = acc[ai][bj][m][n][2 * jp + jj];
                            float t1, t2;
                            if (m == 0) { t1 = X1[jj]; t2 = (fr == 0) ? X2[jj] : X1[jj]; }
                            else { const float prv = acc[ai][bj][m > 0 ? m - 1 : 0][n][2 * jp + jj]; t1 = dpp_keep<0x10F>(0.f, prv); t2 = dpp_keep<0x10E>(0.f, prv); }
                            const float p1 = dpp_keep<0x111>(t1, cur);
                            const float p2 = dpp_keep<0x112>(t2, cur);
                            const float cv = W2[jj] * cur + W1[jj] * p1 + W0[jj] * p2 + BB[jj];
                            if (bj == 0) gq[m][jj] = gelu_tanh(cv); else gq[m][jj] *= cv;
                        }
                    }
                    __builtin_amdgcn_sched_barrier(0);
                }
#pragma unroll
                for (int m = 0; m < 4; ++m)
                    *(unsigned*)(act + (size_t)(rowb + 16 * m) * 3072 + u.pn * 128 + clx + 4 * n + 2 * jp) = pk_bf16(gq[m][0], gq[m][1]);
                __builtin_amdgcn_sched_barrier(0);
            }
        }
    }
    __device__ __forceinline__ void operator()(AccRef acc, const Unit& u, int wr, int wc, int fr, int fq) const {
        const int cl = wc * 32 + 8 * fq;
        if (u.pm >= 64) {
#pragma unroll
            for (int ai = 0; ai < 2; ++ai)
#pragma unroll
                for (int m = 0; m < 4; ++m) {
                    float* dst = ups + (size_t)((u.pm - 64) * 256 + ai * 128 + wr * 64 + m * 16 + fr) * 6144 + u.pn * 128 + cl;
#pragma unroll
                    for (int bj = 0; bj < 2; ++bj)
#pragma unroll
                        for (int n = 0; n < 2; ++n) *(f32x4*)(dst + bj * 3072 + 4 * n) = acc[ai][bj][m][n];
                }
            __builtin_amdgcn_s_barrier(); __builtin_amdgcn_s_barrier();
            return;
        }
        f32x2 cwv; LAS f32x2* cwd;
        {
            const int t = (wr * 4 + wc) * 64 + fq * 16 + fr;
            const int k = t >> 7, rem = (t & 127) * 2, bj = rem >> 7, c2 = rem & 127;
            const float* srcp = (k < 3 ? wdw + (size_t)k * 6144 : bdw) + bj * 3072 + u.pn * 128 + c2;
            cwv = *(const f32x2*)srcp; cwd = (LAS f32x2*)((LAS float*)(exch + LDS_EXCH) + k * 256 + bj * 128 + c2);
        }
        if (fr >= 14) {
#pragma unroll
            for (int ai = 0; ai < 2; ++ai)
#pragma unroll
                for (int bj = 0; bj < 2; ++bj)
#pragma unroll
                    for (int n = 0; n < 2; ++n)
                        *(LAS f32x4*)(exch + (size_t)(((((2 * ai + wr) * 2 + (fr - 14)) * 2 + bj) * 128 + cl + 4 * n) * 4)) = acc[ai][bj][3][n];
        }
        if (wr == 0 && fr < 2) {
#pragma unroll
            for (int bj = 0; bj < 2; ++bj)
#pragma unroll
                for (int n = 0; n < 2; ++n) *(f32x4*)(upa + ((size_t)(u.pm * 2 + fr)) * 6144 + bj * 3072 + u.pn * 128 + cl + 4 * n) = acc[0][bj][0][n];
        }
        if (wr == 1 && fr >= 14) {
#pragma unroll
            for (int bj = 0; bj < 2; ++bj)
#pragma unroll
                for (int n = 0; n < 2; ++n) {
                    *(f32x4*)(upb + ((size_t)(u.pm * 2 + fr - 14)) * 6144 + bj * 3072 + u.pn * 128 + cl + 4 * n) = acc[1][bj][3][n];
                    if ((u.pm & 7) == 7) *(f32x4*)(out + O_FFN_P + ((size_t)((u.pm >> 3) * 2 + fr - 14)) * 6144 + bj * 3072 + u.pn * 128 + cl + 4 * n) = acc[1][bj][3][n];
                }
        }
        *cwd = cwv;
        asm volatile("s_waitcnt lgkmcnt(0)" ::: "memory");
        __builtin_amdgcn_s_barrier(); __builtin_amdgcn_s_barrier();
        asm volatile("" ::: "memory");
        conv_prompt(acc, u, wr, wc, fr, fq);
    }
};

__device__ __forceinline__ void transpose_item(const float* W, int K, int N, bf16_t* WT, int k0, int n0, int nd0, LAS float* scr, int lane) {
#pragma unroll 8
    for (int i = 0; i < 32; ++i) { const int kk = 2 * i + (lane >> 5); scr[kk * 33 + (lane & 31)] = W[(size_t)(k0 + kk) * N + n0 + (lane & 31)]; }
    LDS_FENCE();
    const int c = lane & 7;
#pragma unroll
    for (int j = 0; j < 4; ++j) { const int n = (lane >> 3) + 8 * j; const LAS float* s = scr + (8 * c) * 33 + n;
        u32x4 o; o.x = pk_bf16(s[0 * 33], s[1 * 33]); o.y = pk_bf16(s[2 * 33], s[3 * 33]); o.z = pk_bf16(s[4 * 33], s[5 * 33]); o.w = pk_bf16(s[6 * 33], s[7 * 33]);
        *(u32x4*)(WT + (size_t)(nd0 + n) * K + k0 + 8 * c) = o; }
    LDS_FENCE();
}
__device__ __forceinline__ int perm_in(int n) { if (n >= 2048) return n; const int bj = n >> 10, rem = n & 1023; return 256 * (rem >> 7) + 128 * bj + (rem & 127); }
__device__ __forceinline__ int perm_up(int n) { const int bj = n >= 3072 ? 1 : 0, rem = n - bj * 3072; return 256 * (rem >> 7) + 128 * bj + (rem & 127); }

__device__ __forceinline__ void split8(const float (&v)[8], bf16x8& hi, bf16x8& lo) {
    unsigned h[4], l[4];
#pragma unroll
    for (int i = 0; i < 4; ++i) { h[i] = pk_bf16(v[2 * i], v[2 * i + 1]); l[i] = pk_bf16(v[2 * i] - bf_lo(h[i]), v[2 * i + 1] - bf_hi(h[i])); }
    u32x4 H = {h[0], h[1], h[2], h[3]}, L = {l[0], l[1], l[2], l[3]};
    hi = __builtin_bit_cast(bf16x8, H); lo = __builtin_bit_cast(bf16x8, L);
}

__device__ __forceinline__ void phase0(const Params& P, LAS unsigned char* lds) {
    const int tid = opaque_tid(), lane = tid & 63, wave = tid >> 6, G = gridDim.x, bid = blockIdx.x;
    unsigned char* ws = P.ws;
    {
        LAS float* scr = (LAS float*)(lds + wave * 8448);
        const int gw = bid * NWAVES + wave, NGW = G * NWAVES;
        constexpr int I0 = (1024 / 64) * (DIN / 32), I1 = I0 + (1024 / 64) * (1024 / 32), I2 = I1 + (1280 / 64) * (1024 / 32), I3 = I2 + (1024 / 64) * (1024 / 32),
                      I4 = I3 + (1024 / 64) * (6144 / 32), I5 = I4 + (3072 / 64) * (1024 / 32);
        for (int it = gw; it < I5; it += NGW) {
            const float* W; int K, N, loc, pm; bf16_t* WT;
            if (it < I0) { W = P.in[11]; K = 1024; N = DIN; WT = (bf16_t*)(ws + WS_WIN); loc = it; pm = 1; }
            else if (it < I1) { W = P.in[16]; K = 1024; N = 1024; WT = (bf16_t*)(ws + WS_WCA); loc = it - I0; pm = 0; }
            else if (it < I2) { W = P.in[24]; K = 1280; N = 1024; WT = (bf16_t*)(ws + WS_WRB); loc = it - I1; pm = 0; }
            else if (it < I3) { W = P.in[25]; K = 1024; N = 1024; WT = (bf16_t*)(ws + WS_WO); loc = it - I2; pm = 0; }
            else if (it < I4) { W = P.in[27]; K = 1024; N = 6144; WT = (bf16_t*)(ws + WS_WUP); loc = it - I3; pm = 2; }
            else { W = P.in[30]; K = 3072; N = 1024; WT = (bf16_t*)(ws + WS_WDN); loc = it - I4; pm = 0; }
            const int nblk = N / 32, kb = loc / nblk, nb = loc % nblk, n0 = nb * 32;
            const int nd0 = pm == 1 ? perm_in(n0) : (pm == 2 ? perm_up(n0) : n0);
            transpose_item(W, K, N, WT, kb * 64, n0, nd0, scr, lane);
        }
    }
    {
        const int gt = bid * NTHREADS + tid, NT = G * NTHREADS;
        bf16_t* wrg = (bf16_t*)(ws + WS_WRG); bf16_t* wig = (bf16_t*)(ws + WS_WIG);
        for (int e = gt; e < 8 * 160 * 160; e += NT) { const int g = e / 25600, rem = e % 25600, j = rem / 160, i = rem % 160;
            const size_t src = (size_t)g * 25600 + (size_t)i * 160 + j;
            wrg[e] = (bf16_t)(pk_bf16(P.in[19][src], 0.f) & 0xffffu); wig[e] = (bf16_t)(pk_bf16(P.in[21][src], 0.f) & 0xffffu); }
        for (int e = gt; e < 1280; e += NT) ((float*)(ws + WS_SP8))[e] = 8.0f * log1pf(expf(-P.in[23][e]));
        for (int e = gt; e < 144 * 128; e += NT) { const int row = e >> 7, k8 = (e & 127) * 8;
            float av[8];
#pragma unroll
            for (int i = 0; i < 8; ++i) av[i] = 0.f;
            if (row < NBATCH) { const float* cp = (row < 8) ? P.in[6] + (size_t)row * 1024 : P.in[7] + (size_t)(row - 8) * 1024;
                const f32x4 c0 = *(const f32x4*)(cp + k8), c1 = *(const f32x4*)(cp + k8 + 4);
#pragma unroll
                for (int i = 0; i < 4; ++i) { av[i] = siluf_(c0[i]); av[4 + i] = siluf_(c1[i]); } }
            bf16x8 hi, lo; split8(av, hi, lo);
            *(bf16x8*)((bf16_t*)(ws + WS_SCH) + (size_t)row * 1024 + k8) = hi; *(bf16x8*)((bf16_t*)(ws + WS_SCL) + (size_t)row * 1024 + k8) = lo; }
        const f32x4* st = (const f32x4*)P.in[2]; f32x4* dst = (f32x4*)(P.out + O_CONF_S);
        for (int e = gt; e < 128 * 22 * 256; e += NT) { const int b = e / (22 * 256), rem = e % (22 * 256), i = rem / 256, c4 = rem % 256;
            dst[((size_t)b * 30 + i) * 256 + c4] = st[((size_t)b * 30 + i + 8) * 256 + c4]; }
    }
}
__device__ __forceinline__ void phase0_mod(const Params& P, LAS unsigned char* lds) {
    const int tid = opaque_tid(), lane = tid & 63, wave = tid >> 6, G = gridDim.x, bid = blockIdx.x;
    unsigned char* ws = P.ws;
    {
        const int fr = lane & 15, fq = lane >> 4;
        LAS float* red = (LAS float*)lds;
        const float* wada = P.in[8]; const float* bada = P.in[9];
        const bf16_t* sch = (const bf16_t*)(ws + WS_SCH); const bf16_t* scl = (const bf16_t*)(ws + WS_SCL);
        float* mod = (float*)(ws + WS_MOD);
        for (int task = bid; task < NMOD / 32; task += G) {
            const int n0 = task * 32, kbase = wave * 128;
            f32x4 acc[2][9];
#pragma unroll
            for (int t = 0; t < 2; ++t)
#pragma unroll
                for (int i = 0; i < 9; ++i) acc[t][i] = (f32x4){0.f, 0.f, 0.f, 0.f};
#pragma unroll 1
            for (int ks = 0; ks < 4; ++ks) {
                const int k0 = kbase + ks * 32 + fq * 8;
                float bv0[8], bv1[8];
#pragma unroll
                for (int i = 0; i < 8; ++i) { bv0[i] = wada[(size_t)(k0 + i) * NMOD + n0 + fr]; bv1[i] = wada[(size_t)(k0 + i) * NMOD + n0 + 16 + fr]; }
                bf16x8 ah[9], al[9];
#pragma unroll
                for (int rt = 0; rt < 9; ++rt) { ah[rt] = *(const bf16x8*)(sch + (size_t)(rt * 16 + fr) * 1024 + k0); al[rt] = *(const bf16x8*)(scl + (size_t)(rt * 16 + fr) * 1024 + k0); }
                bf16x8 bh0, bl0, bh1, bl1; split8(bv0, bh0, bl0); split8(bv1, bh1, bl1);
#pragma unroll
                for (int rt = 0; rt < 9; ++rt) {
                    acc[0][rt] = __builtin_amdgcn_mfma_f32_16x16x32_bf16(ah[rt], bh0, acc[0][rt], 0, 0, 0);
                    acc[0][rt] = __builtin_amdgcn_mfma_f32_16x16x32_bf16(al[rt], bh0, acc[0][rt], 0, 0, 0);
                    acc[0][rt] = __builtin_amdgcn_mfma_f32_16x16x32_bf16(ah[rt], bl0, acc[0][rt], 0, 0, 0);
                    acc[1][rt] = __builtin_amdgcn_mfma_f32_16x16x32_bf16(ah[rt], bh1, acc[1][rt], 0, 0, 0);
                    acc[1][rt] = __builtin_amdgcn_mfma_f32_16x16x32_bf16(al[rt], bh1, acc[1][rt], 0, 0, 0);
                    acc[1][rt] = __builtin_amdgcn_mfma_f32_16x16x32_bf16(ah[rt], bl1, acc[1][rt], 0, 0, 0);
                }
            }
#pragma unroll
            for (int t = 0; t < 2; ++t) {
#pragma unroll
                for (int rt = 0; rt < 9; ++rt)
#pragma unroll
                    for (int j = 0; j < 4; ++j) red[(wave * 144 + rt * 16 + fq * 4 + j) * 16 + fr] = acc[t][rt][j];
                __syncthreads();
                for (int idx = tid; idx < NBATCH * 16; idx += NTHREADS) { const int row = idx >> 4, col = idx & 15;
                    float s = bada[n0 + t * 16 + col];
#pragma unroll
                    for (int w = 0; w < 8; ++w) s += red[(w * 144 + row) * 16 + col];
                    mod[(size_t)row * NMOD + n0 + t * 16 + col] = s; }
                __syncthreads();
            }
        }
    }
}

template <int MODE>
__device__ __forceinline__ void phase_norm(const float* xp, const float* xs, const bf16_t* xb, const float* g, const float* mod, int shift_off, int scale_off, bf16_t* dst, float* ydst) {
    const int tid = opaque_tid(), lane = tid & 63, wave = tid >> 6;
    const int gw = blockIdx.x * NWAVES + wave, NGW = gridDim.x * NWAVES;
    for (int row0 = gw; row0 < MT; row0 += 2 * NGW) {
        f32x4 v[2][4], gv[4], sc[2][4], sh[2][4];
        int rows[2]; rows[0] = row0; rows[1] = (row0 + NGW < MT) ? row0 + NGW : row0;
#pragma unroll
        for (int j = 0; j < 4; ++j) gv[j] = *(const f32x4*)(g + 4 * lane + 256 * j);
#pragma unroll
        for (int t = 0; t < 2; ++t) {
            const int row = rows[t];
            if (MODE == 0) { const float* xr = (row < MP) ? xp + (size_t)row * 1024 : xs + (size_t)(row - MP) * 1024;
#pragma unroll
                for (int j = 0; j < 4; ++j) v[t][j] = *(const f32x4*)(xr + 4 * lane + 256 * j); }
            else {
#pragma unroll
                for (int j = 0; j < 4; ++j) { const u32x2 w = *(const u32x2*)(xb + (size_t)row * 1024 + 4 * lane + 256 * j); v[t][j] = (f32x4){bf_lo(w.x), bf_hi(w.x), bf_lo(w.y), bf_hi(w.y)}; } }
            if (MODE != 2) { const float* mp = mod + (size_t)batch_of_row(row) * NMOD;
#pragma unroll
                for (int j = 0; j < 4; ++j) { sc[t][j] = *(const f32x4*)(mp + scale_off + 4 * lane + 256 * j); sh[t][j] = *(const f32x4*)(mp + shift_off + 4 * lane + 256 * j); } }
        }
#pragma unroll
        for (int t = 0; t < 2; ++t) {
            const int row = rows[t];
            float ss = 0.f;
#pragma unroll
            for (int j = 0; j < 4; ++j) ss += v[t][j][0] * v[t][j][0] + v[t][j][1] * v[t][j][1] + v[t][j][2] * v[t][j][2] + v[t][j][3] * v[t][j][3];
            const float rstd = rsqrtf(wave_sum(ss) * (1.0f / 1024.0f) + EPS);
#pragma unroll
            for (int j = 0; j < 4; ++j) {
                const int c = 4 * lane + 256 * j;
                if (MODE == 2) { *(f32x4*)(ydst + (size_t)row * 1024 + c) = v[t][j] * rstd * gv[j]; }
                else {
                    f32x4 o;
#pragma unroll
                    for (int i = 0; i < 4; ++i) o[i] = v[t][j][i] * rstd * gv[j][i] * (1.0f + sc[t][j][i]) + sh[t][j][i];
                    u32x2 w; w.x = pk_bf16(o[0], o[1]); w.y = pk_bf16(o[2], o[3]);
                    *(u32x2*)(dst + (size_t)row * 1024 + c) = w;
                }
            }
        }
    }
}

constexpr int RB_RAW = 0, RB_XRB = 21504, RB_SA = 43008, RB_SB = 84992, RB_CAR = 126976;
__device__ __forceinline__ float neg_expm1(float x) {
    const float p = -x * (1.0f + x * (0.5f + x * (0.16666667f + x * (0.041666668f + x * (0.008333334f + x * 0.0013888889f)))));
    return (x > -0.25f) ? p : 1.0f - __expf(x);
}
struct RgPre { u32x4 v[3]; float cst; };
__device__ __forceinline__ void rglru_prefetch(const Params& P, int q, int tid, RgPre& pre) {
    const bf16_t* rnnx = (const bf16_t*)(P.ws + WS_S2);
    const bool sample = q >= 2048;
    int g, r0, c = 0;
    if (!sample) { g = q & 7; c = (q >> 3) & 31; r0 = (q >> 8) * 2048 + c * 64; }
    else { const int qs = q - 2048; g = qs & 7; r0 = MP + (qs >> 3) * 64; }
#pragma unroll
    for (int u = 0; u < 3; ++u) { const int idx = u * NTHREADS + tid, i = idx / 20, ck = idx % 20;
        pre.v[u] = (u32x4){0u, 0u, 0u, 0u};
        const bool valid = (idx < 67 * 20) && (sample ? (i >= 3) : (c > 0 || i >= 3));
        if (valid) pre.v[u] = *(const u32x4*)(rnnx + (size_t)(r0 - 3 + i) * 1280 + g * 160 + ck * 8); }
    pre.cst = 0.f;
    if (tid < 480) { const int k = tid / 160, cc = tid % 160; const float* sp = (k == 0) ? P.in[20] : (k == 1 ? P.in[22] : (const float*)(P.ws + WS_SP8)); pre.cst = sp[g * 160 + cc]; }
}
__device__ __forceinline__ void rglru_task(const Params& P, LAS unsigned char* lds, int q, RgPre& pre, int qn) {
    const int tid = opaque_tid(), lane = tid & 63, wave = tid >> 6, fr = lane & 15, fq = lane >> 4;
    unsigned char* ws = P.ws;
    const bf16_t* rnnx = (const bf16_t*)(ws + WS_S2);
    bf16_t* gghg = (bf16_t*)(ws + WS_S3); bf16_t* pg = (bf16_t*)(ws + WS_S4);
    const bool sample = q >= 2048;
    int g, r0, b = 0, c = 0, sb0 = 0;
    if (!sample) { g = q & 7; c = (q >> 3) & 31; b = q >> 8; r0 = b * 2048 + c * 64; }
    else { const int qs = q - 2048; g = qs & 7; sb0 = (qs >> 3) * 8; r0 = MP + (qs >> 3) * 64; }
    LAS bf16_t* RAW = (LAS bf16_t*)(lds + RB_RAW);
    LAS bf16_t* XRB = (LAS bf16_t*)(lds + RB_XRB);
    LAS float* SA = (LAS float*)(lds + RB_SA);
    LAS float* SB = (LAS float*)(lds + RB_SB);
    LAS float* CAR = (LAS float*)(lds + RB_CAR);
    LAS float* CST = (LAS float*)(lds + LDS_STAGE);
    const bf16_t* wrg = (const bf16_t*)(ws + WS_WRG) + (size_t)g * 25600; const bf16_t* wig = (const bf16_t*)(ws + WS_WIG) + (size_t)g * 25600;
    int ctc = (wave * 5) >> 2;
    bf16x8 fwr[5], fwi[5];
#pragma unroll
    for (int ks = 0; ks < 5; ++ks) { fwr[ks] = *(const bf16x8*)(wrg + (size_t)(ctc * 16 + fr) * 160 + ks * 32 + fq * 8); fwi[ks] = *(const bf16x8*)(wig + (size_t)(ctc * 16 + fr) * 160 + ks * 32 + fq * 8); }
    if (tid < 480) CST[tid] = pre.cst;
#pragma unroll
    for (int u = 0; u < 3; ++u) { const int idx = u * NTHREADS + tid, i = idx / 20, ck = idx % 20;
        if (idx < 67 * 20) *(LAS u32x4*)(RAW + i * 160 + ck * 8) = pre.v[u]; }
    __syncthreads();
    if (tid < 480) {
        const int cp = tid % 80, rg = tid / 80, ch = cp * 2, chg = g * 160 + ch;
        const f32x2 bs = *(const f32x2*)(P.in[18] + chg);
        f32x2 w[4];
#pragma unroll
        for (int j = 0; j < 4; ++j) w[j] = *(const f32x2*)(P.in[17] + (size_t)j * 1280 + chg);
        const int lr0 = rg * 11, lr1 = (lr0 + 11 < 64) ? lr0 + 11 : 64;
        if (!sample) {
            unsigned x0 = *(const LAS unsigned*)(RAW + (lr0 + 0) * 160 + ch), x1 = *(const LAS unsigned*)(RAW + (lr0 + 1) * 160 + ch), x2 = *(const LAS unsigned*)(RAW + (lr0 + 2) * 160 + ch);
            for (int lr = lr0; lr < lr1; ++lr) {
                const unsigned x3 = *(const LAS unsigned*)(RAW + (lr + 3) * 160 + ch);
                const float a0 = bs[0] + w[0][0] * bf_lo(x0) + w[1][0] * bf_lo(x1) + w[2][0] * bf_lo(x2) + w[3][0] * bf_lo(x3);
                const float a1 = bs[1] + w[0][1] * bf_hi(x0) + w[1][1] * bf_hi(x1) + w[2][1] * bf_hi(x2) + w[3][1] * bf_hi(x3);
                *(LAS unsigned*)(XRB + lr * 168 + ch) = pk_bf16(a0, a1);
                x0 = x1; x1 = x2; x2 = x3;
            }
        } else {
            for (int lr = lr0; lr < lr1; ++lr) {
                const int t = lr & 7;
                f32x2 a = bs;
#pragma unroll
                for (int j = 0; j < 4; ++j) {
                    float x0, x1;
                    if (t + j < 3) { const f32x2 sv = *(const f32x2*)(P.in[3] + ((size_t)(sb0 + (lr >> 3)) * 3 + t + j) * 1280 + chg); x0 = sv[0]; x1 = sv[1]; }
                    else { const unsigned rw = *(const LAS unsigned*)(RAW + (lr + j) * 160 + ch); x0 = bf_lo(rw); x1 = bf_hi(rw); }
                    a[0] += w[j][0] * x0; a[1] += w[j][1] * x1;
                }
                *(LAS unsigned*)(XRB + lr * 168 + ch) = pk_bf16(a[0], a[1]);
            }
        }
    }
    __syncthreads();
    if (qn >= 0) rglru_prefetch(P, qn, tid, pre);
    u32x4 gpre[3];
#pragma unroll
    for (int u = 0; u < 3; ++u) { const int idx = u * NTHREADS + tid; gpre[u] = (u32x4){0u, 0u, 0u, 0u};
        if (idx < 64 * 20) gpre[u] = *(const u32x4*)(gghg + (size_t)(r0 + idx / 20) * 1280 + g * 160 + (idx % 20) * 8); }
    {
#pragma unroll
        for (int i = 0; i < 5; ++i) {
            const int idx = wave * 5 + i, ct = idx >> 2, rt = idx & 3;
            if (ct != ctc) { ctc = ct;
#pragma unroll
                for (int ks = 0; ks < 5; ++ks) { fwr[ks] = *(const bf16x8*)(wrg + (size_t)(ct * 16 + fr) * 160 + ks * 32 + fq * 8); fwi[ks] = *(const bf16x8*)(wig + (size_t)(ct * 16 + fr) * 160 + ks * 32 + fq * 8); } }
            f32x4 ar = {0.f, 0.f, 0.f, 0.f}, ai = {0.f, 0.f, 0.f, 0.f};
#pragma unroll
            for (int ks = 0; ks < 5; ++ks) {
                const bf16x8 xb = *(const LAS bf16x8*)(XRB + (rt * 16 + fr) * 168 + ks * 32 + fq * 8);
                ar = __builtin_amdgcn_mfma_f32_16x16x32_bf16(fwr[ks], xb, ar, 0, 0, 0);
                ai = __builtin_amdgcn_mfma_f32_16x16x32_bf16(fwi[ks], xb, ai, 0, 0, 0);
            }
            const int chl = ct * 16 + fq * 4, chg = g * 160 + chl, lr = rt * 16 + fr;
            const f32x4 brg = *(const LAS f32x4*)(CST + chl), big = *(const LAS f32x4*)(CST + 160 + chl), sp8 = *(const LAS f32x4*)(CST + 320 + chl);
            const u32x2 xw = *(const LAS u32x2*)(XRB + lr * 168 + chl);
            const float xr[4] = {bf_lo(xw.x), bf_hi(xw.x), bf_lo(xw.y), bf_hi(xw.y)};
            f32x4 av, bx;
#pragma unroll
            for (int jp = 0; jp < 2; ++jp) {
                const f32x2 zr = {ar[2 * jp] + brg[2 * jp], ar[2 * jp + 1] + brg[2 * jp + 1]}, zi = {ai[2 * jp] + big[2 * jp], ai[2 * jp + 1] + big[2 * jp + 1]};
                const f32x2 r = sigmoid2(zr), ig = sigmoid2(zi);
                const f32x2 sp = {sp8[2 * jp], sp8[2 * jp + 1]}, xv = {xr[2 * jp], xr[2 * jp + 1]};
                const f32x2 la = -(r * sp);
                const f32x2 tl = la * 1.4426950408889634f;
                av[2 * jp] = __builtin_amdgcn_exp2f(tl.x); av[2 * jp + 1] = __builtin_amdgcn_exp2f(tl.y);
                const f32x2 x2 = la + la;
                f32x2 m2 = -x2 * (1.0f + x2 * (0.5f + x2 * (0.16666667f + x2 * (0.041666668f + x2 * (0.008333334f + x2 * 0.0013888889f)))));
                if (__builtin_amdgcn_ballot_w64(x2.x <= -0.25f || x2.y <= -0.25f) != 0ull) {
                    m2.x = (x2.x > -0.25f) ? m2.x : 1.0f - __expf(x2.x); m2.y = (x2.y > -0.25f) ? m2.y : 1.0f - __expf(x2.y); }
                f32x2 sq; sq.x = __builtin_sqrtf(m2.x); sq.y = __builtin_sqrtf(m2.y);
                const f32x2 bxv = sq * ig * xv;
                bx[2 * jp] = bxv.x; bx[2 * jp + 1] = bxv.y;
            }
            *(LAS f32x4*)(SA + lr * 164 + chl) = av; *(LAS f32x4*)(SB + lr * 164 + chl) = bx;
        }
    }
    __syncthreads();
    if (tid < 480) {
        const int ch = tid % 160, sg = tid / 160, chg = g * 160 + ch;
        if (!sample) {
            const int lr0 = sg == 0 ? 0 : (sg == 1 ? 22 : 43), lr1 = sg == 0 ? 22 : (sg == 1 ? 43 : 64);
            float h = 0.f, pr = 1.f;
            float av[22], bv[22];
#pragma unroll
            for (int i = 0; i < 22; ++i) { const int lr = (lr0 + i < lr1) ? lr0 + i : lr1 - 1; av[i] = SA[lr * 164 + ch]; bv[i] = SB[lr * 164 + ch]; }
#pragma unroll
            for (int i = 0; i < 22; ++i) { if (lr0 + i < lr1) { h = av[i] * h + bv[i]; pr *= av[i]; } bv[i] = h; av[i] = pr; }
#pragma unroll
            for (int i = 0; i < 22; ++i) { if (lr0 + i < lr1) { SB[(lr0 + i) * 164 + ch] = bv[i]; SA[(lr0 + i) * 164 + ch] = av[i]; } }
            CAR[sg * 160 + ch] = h; CAR[480 + sg * 160 + ch] = pr;
        } else {
            const int s0 = sg * 3, s1 = (s0 + 3 < 8) ? s0 + 3 : 8;
            for (int s = s0; s < s1; ++s) {
                float h = P.in[4][(size_t)(sb0 + s) * 1280 + chg];
#pragma unroll
                for (int t = 0; t < 8; ++t) { const int lr = s * 8 + t; h = SA[lr * 164 + ch] * h + SB[lr * 164 + ch]; SB[lr * 164 + ch] = h; }
                P.out[O_H_S + (size_t)(sb0 + s) * 1280 + chg] = h;
            }
        }
    }
    __syncthreads();
    if (!sample && tid < 160) {
        const float h0 = CAR[tid], h1 = CAR[160 + tid], h2 = CAR[320 + tid], p0 = CAR[480 + tid], p1 = CAR[640 + tid], p2 = CAR[800 + tid];
        const float c1 = h0, c2 = h1 + p1 * c1;
        ((float*)(ws + WS_HL))[((size_t)b * 32 + c) * 1280 + g * 160 + tid] = h2 + p2 * c2;
        ((float*)(ws + WS_PL))[((size_t)b * 32 + c) * 1280 + g * 160 + tid] = p0 * p1 * p2;
    }
#pragma unroll
    for (int u = 0; u < 3; ++u) { const int idx = u * NTHREADS + tid; if (idx >= 64 * 20) break; const int lr = idx / 20, ch = (idx % 20) * 8;
        const size_t off = (size_t)(r0 + lr) * 1280 + g * 160 + ch;
        const u32x4 gw = gpre[u];
        const float gv[8] = {bf_lo(gw.x), bf_hi(gw.x), bf_lo(gw.y), bf_hi(gw.y), bf_lo(gw.z), bf_hi(gw.z), bf_lo(gw.w), bf_hi(gw.w)};
        f32x4 h0 = *(const LAS f32x4*)(SB + lr * 164 + ch), h1 = *(const LAS f32x4*)(SB + lr * 164 + ch + 4);
        if (!sample) {
            f32x4 p0 = *(const LAS f32x4*)(SA + lr * 164 + ch), p1 = *(const LAS f32x4*)(SA + lr * 164 + ch + 4);
            if (lr >= 22) {
                const int sg = lr >= 43 ? 2 : 1;
#pragma unroll
                for (int k = 0; k < 2; ++k) {
                    const f32x4 e0 = *(const LAS f32x4*)(CAR + ch + 4 * k), q0 = *(const LAS f32x4*)(CAR + 480 + ch + 4 * k);
                    f32x4 cin = e0, qin = q0;
                    if (sg == 2) { const f32x4 e1 = *(const LAS f32x4*)(CAR + 160 + ch + 4 * k), q1 = *(const LAS f32x4*)(CAR + 640 + ch + 4 * k); cin = e1 + q1 * e0; qin = q0 * q1; }
                    if (k == 0) { h0 = h0 + p0 * cin; p0 = p0 * qin; } else { h1 = h1 + p1 * cin; p1 = p1 * qin; }
                }
            }
            u32x4 o2; o2.x = pk_bf16(p0[0] * gv[0], p0[1] * gv[1]); o2.y = pk_bf16(p0[2] * gv[2], p0[3] * gv[3]); o2.z = pk_bf16(p1[0] * gv[4], p1[1] * gv[5]); o2.w = pk_bf16(p1[2] * gv[6], p1[3] * gv[7]);
            *(u32x4*)(pg + off) = o2;
        }
        u32x4 o; o.x = pk_bf16(h0[0] * gv[0], h0[1] * gv[1]); o.y = pk_bf16(h0[2] * gv[2], h0[3] * gv[3]); o.z = pk_bf16(h1[0] * gv[4], h1[1] * gv[5]); o.w = pk_bf16(h1[2] * gv[6], h1[3] * gv[7]);
        *(u32x4*)(gghg + off) = o; }
    __syncthreads();
}

struct CfPre { u32x4 v[12]; };
__device__ __forceinline__ void conf_prefetch(const Params& P, int r0, int t0, int tid, CfPre& pre) {
    const bf16_t* uglu = (const bf16_t*)(P.ws + WS_S1);
#pragma unroll
    for (int u = 0; u < 12; ++u) { const int idx = u * NTHREADS + tid, i = idx >> 7, ck = idx & 127;
        pre.v[u] = (u32x4){0u, 0u, 0u, 0u};
        if (idx < 46 * 128 && t0 - 30 + i >= 0) pre.v[u] = *(const u32x4*)(uglu + (size_t)(r0 - 30 + i) * 1024 + ck * 8); }
}
template <int R, bool USEPRE>
__device__ __forceinline__ void conf_task(const Params& P, LAS unsigned char* lds, int r0, int t0, int sb, bool sample, const f32x2 (&w)[31], f32x2 bias, CfPre& pre, int nr0, int nt0) {
    const int tid = opaque_tid(), lane = tid & 63, wave = tid >> 6;
    const bf16_t* uglu = (const bf16_t*)(P.ws + WS_S1);
    bf16_t* ua = (bf16_t*)(P.ws + WS_S0);
    LAS bf16_t* ST = (LAS bf16_t*)lds;
    if (USEPRE) {
#pragma unroll
        for (int u = 0; u < 12; ++u) { const int idx = u * NTHREADS + tid, i = idx >> 7, ck = idx & 127;
            if (idx < 46 * 128) *(LAS u32x4*)(ST + i * 1024 + ck * 8) = pre.v[u]; }
    } else
    {
        constexpr int NCH = (R + 30) * 128, PER = (NCH + NTHREADS - 1) / NTHREADS, NB = PER / 2;
#pragma unroll
        for (int h = 0; h < 2; ++h) {
            u32x4 v[NB]; f32x4 fa[NB], fb[NB];
#pragma unroll
            for (int u = 0; u < NB; ++u) {
                const int idx = (h * NB + u) * NTHREADS + tid, i = idx >> 7, ck = idx & 127;
                v[u] = (u32x4){0u, 0u, 0u, 0u}; fa[u] = (f32x4){0.f, 0.f, 0.f, 0.f}; fb[u] = fa[u];
                if (idx < NCH) {
                    if (!sample) { if (t0 - 30 + i >= 0) v[u] = *(const u32x4*)(uglu + (size_t)(r0 - 30 + i) * 1024 + ck * 8); }
                    else if (i < 30) { const float* sp = P.in[2] + ((size_t)sb * 30 + i) * 1024 + ck * 8; fa[u] = *(const f32x4*)sp; fb[u] = *(const f32x4*)(sp + 4); }
                    else v[u] = *(const u32x4*)(uglu + (size_t)(r0 + i - 30) * 1024 + ck * 8);
                }
            }
#pragma unroll
            for (int u = 0; u < NB; ++u) {
                const int idx = (h * NB + u) * NTHREADS + tid, i = idx >> 7, ck = idx & 127;
                if (idx < NCH) {
                    u32x4 o = v[u];
                    if (sample && i < 30) { o.x = pk_bf16(fa[u][0], fa[u][1]); o.y = pk_bf16(fa[u][2], fa[u][3]); o.z = pk_bf16(fb[u][0], fb[u][1]); o.w = pk_bf16(fb[u][2], fb[u][3]); }
                    *(LAS u32x4*)(ST + i * 1024 + ck * 8) = o;
                }
            }
        }
    }
    __syncthreads();
    if (USEPRE && nr0 >= 0) conf_prefetch(P, nr0, nt0, tid, pre);
    f32x2 acc[R];
#pragma unroll
    for (int r = 0; r < R; ++r) acc[r] = bias;
#pragma unroll
    for (int i = 0; i < R + 30; ++i) {
        const unsigned rw = *(const LAS unsigned*)(ST + i * 1024 + 2 * tid);
        const f32x2 v = {bf_lo(rw), bf_hi(rw)};
#pragma unroll
        for (int r = 0; r < R; ++r) { const int tap = i - r; if (tap >= 0 && tap <= 30) acc[r] += v * w[tap]; }
    }
    __syncthreads();
    LAS float* CO = (LAS float*)lds;
#pragma unroll
    for (int r = 0; r < R; ++r) *(LAS f32x2*)(CO + r * 1024 + 2 * tid) = acc[r];
    __syncthreads();
    for (int r = wave; r < R; r += NWAVES) {
        f32x4 v[4]; float s = 0.f;
#pragma unroll
        for (int k = 0; k < 4; ++k) { v[k] = *(const LAS f32x4*)(CO + r * 1024 + 4 * lane + 256 * k); s += (v[k][0] + v[k][1]) + (v[k][2] + v[k][3]); }
        const float mean = wave_sum(s) * (1.0f / 1024.0f); float s2 = 0.f;
#pragma unroll
        for (int k = 0; k < 4; ++k) { v[k] = v[k] - mean; s2 += (v[k][0] * v[k][0] + v[k][1] * v[k][1]) + (v[k][2] * v[k][2] + v[k][3] * v[k][3]); }
        const float rstd = rsqrtf(wave_sum(s2) * (1.0f / 1024.0f) + EPS);
#pragma unroll
        for (int k = 0; k < 4; ++k) { const int c = 4 * lane + 256 * k;
            const f32x4 gv = *(const f32x4*)(P.in[14] + c), bv = *(const f32x4*)(P.in[15] + c);
            float o[4];
#pragma unroll
            for (int i = 0; i < 4; ++i) o[i] = siluf_(v[k][i] * rstd * gv[i] + bv[i]);
            u32x2 wv; wv.x = pk_bf16(o[0], o[1]); wv.y = pk_bf16(o[2], o[3]);
            *(u32x2*)(ua + (size_t)(r0 + r) * 1024 + c) = wv; }
    }
    __syncthreads();
}

__device__ __forceinline__ void fix_task(const Params& P, LAS unsigned char* lds, int q) {
    const int tid = opaque_tid();
    const int b = q / 31, c = 1 + q % 31;
    LAS float* Hs = (LAS float*)lds;
    const float* hl = (const float*)(P.ws + WS_HL) + (size_t)b * 32 * 1280; const float* pl = (const float*)(P.ws + WS_PL) + (size_t)b * 32 * 1280;
    for (int ch = tid; ch < 1280; ch += NTHREADS) {
        float hv[32], pv[32];
#pragma unroll
        for (int cc = 0; cc < 32; ++cc) { const int ce = cc <= c ? cc : c; hv[cc] = hl[(size_t)ce * 1280 + ch]; pv[cc] = pl[(size_t)ce * 1280 + ch]; }
        float H = 0.f;
#pragma unroll
        for (int cc = 0; cc < 31; ++cc) H = (cc < c) ? hv[cc] + pv[cc] * H : H;
        Hs[ch] = H;
        if (c == 31) P.out[O_H_P + (size_t)b * 1280 + ch] = hv[31] + pv[31] * H;
    }
    __syncthreads();
    bf16_t* hg = (bf16_t*)(P.ws + WS_S3); const bf16_t* pg = (const bf16_t*)(P.ws + WS_S4);
    const int r0 = b * 2048 + c * 64;
    for (int base = 0; base < 64 * 160; base += 4 * NTHREADS) {
        u32x4 hw[4], pw[4];
#pragma unroll
        for (int u = 0; u < 4; ++u) { const int idx = base + u * NTHREADS + tid, lr = idx / 160, ch = (idx % 160) * 8; const size_t off = (size_t)(r0 + lr) * 1280 + ch;
            hw[u] = *(const u32x4*)(hg + off); pw[u] = *(const u32x4*)(pg + off); }
#pragma unroll
        for (int u = 0; u < 4; ++u) { const int idx = base + u * NTHREADS + tid, lr = idx / 160, ch = (idx % 160) * 8; const size_t off = (size_t)(r0 + lr) * 1280 + ch;
            const f32x4 H0 = *(const LAS f32x4*)(Hs + ch), H1 = *(const LAS f32x4*)(Hs + ch + 4);
            u32x4 o;
            o.x = pk_bf16(bf_lo(hw[u].x) + bf_lo(pw[u].x) * H0[0], bf_hi(hw[u].x) + bf_hi(pw[u].x) * H0[1]);
            o.y = pk_bf16(bf_lo(hw[u].y) + bf_lo(pw[u].y) * H0[2], bf_hi(hw[u].y) + bf_hi(pw[u].y) * H0[3]);
            o.z = pk_bf16(bf_lo(hw[u].z) + bf_lo(pw[u].z) * H1[0], bf_hi(hw[u].z) + bf_hi(pw[u].z) * H1[1]);
            o.w = pk_bf16(bf_lo(hw[u].w) + bf_lo(pw[u].w) * H1[2], bf_hi(hw[u].w) + bf_hi(pw[u].w) * H1[3]);
            *(u32x4*)(hg + off) = o; }
    }
    __syncthreads();
}

template <int K>
__device__ __forceinline__ void small_gemm(LAS unsigned char* lds, const bf16_t* A, const bf16_t* Bt, int m0, int n0, int tid, f32x4 (&acc)[2]) {
    static_assert(K % 128 == 0, "K multiple of 128");
    constexpr int RS = 272, ABYTES = 128 * RS, BUF = 160 * RS;
    const int lane = tid & 63, wave = tid >> 6, fr = lane & 15, fq = lane >> 4;
    const int srow = tid >> 4, sc = tid & 15;
    const bf16_t* ga = A + (size_t)(m0 + srow) * K + sc * 8;
    const bf16_t* gb = Bt + (size_t)(n0 + srow) * K + sc * 8;
    static_assert((K / 128) % 2 == 0, "even number of K-chunks");
    u32x4 r0[4], r0b, r1[4], r1b;
#define SG_LOAD(R, RB, c) do { _Pragma("unroll") for (int u = 0; u < 4; ++u) R[u] = *(const u32x4*)(ga + (size_t)(32 * u) * K + (c) * 128); RB = *(const u32x4*)(gb + (c) * 128); } while (0)
#define SG_STORE(R, RB, buf) do { _Pragma("unroll") for (int u = 0; u < 4; ++u) *(LAS u32x4*)((buf) + (srow + 32 * u) * RS + sc * 16) = R[u]; *(LAS u32x4*)((buf) + ABYTES + srow * RS + sc * 16) = RB; } while (0)
#define SG_COMPUTE(buf) do { _Pragma("unroll") for (int ks = 0; ks < 4; ++ks) { \
        const bf16x8 a = *(const LAS bf16x8*)((buf) + aoff + ks * 64), b0 = *(const LAS bf16x8*)((buf) + boff + ks * 64), b1 = *(const LAS bf16x8*)((buf) + boff + 16 * RS + ks * 64); \
        acc[0] = __builtin_amdgcn_mfma_f32_16x16x32_bf16(b0, a, acc[0], 0, 0, 0); acc[1] = __builtin_amdgcn_mfma_f32_16x16x32_bf16(b1, a, acc[1], 0, 0, 0); } } while (0)
    const int aoff = (wave * 16 + fr) * RS + fq * 16, boff = ABYTES + fr * RS + fq * 16;
    LAS unsigned char* buf0 = lds; LAS unsigned char* buf1 = lds + BUF;
    SG_LOAD(r0, r0b, 0); SG_LOAD(r1, r1b, 1);
    SG_STORE(r0, r0b, buf0);
    __syncthreads();
#pragma unroll 1
    for (int kc = 0; kc < K / 128; kc += 2) {
        if (kc + 2 < K / 128) SG_LOAD(r0, r0b, kc + 2);
        SG_COMPUTE(buf0);
        SG_STORE(r1, r1b, buf1);
        __syncthreads();
        if (kc + 3 < K / 128) SG_LOAD(r1, r1b, kc + 3);
        SG_COMPUTE(buf1);
        if (kc + 2 < K / 128) SG_STORE(r0, r0b, buf0);
        __syncthreads();
    }
#undef SG_LOAD
#undef SG_STORE
#undef SG_COMPUTE
}

#define XB_TMO      128
#define XB_XCNT(j)  (256  + 64 * (j))
#define XB_XSUB(j)  (1280 + 64 * (j))
#define XB_XGEN(j)  (2304 + 64 * (j))
#define XB_TOP      3328
#define XB_TOPGEN   3392
#define XCD_BAR_WORDS 3456
#define XB_SPIN_CAP (1u << 18)
__device__ __forceinline__ unsigned xb_ld(unsigned* p)              { return __hip_atomic_load(p, __ATOMIC_RELAXED, __HIP_MEMORY_SCOPE_AGENT); }
__device__ __forceinline__ unsigned xb_add(unsigned* p, unsigned v) { return __hip_atomic_fetch_add(p, v, __ATOMIC_RELAXED, __HIP_MEMORY_SCOPE_AGENT); }
__device__ __forceinline__ unsigned xb_xcc_id() { return (unsigned)__builtin_amdgcn_s_getreg((3 << 11) | 20) & 0xFu; }
#define XB_SPIN(cond, bar) do { unsigned _sp = 0; while (cond) { __builtin_amdgcn_s_sleep(1); \
    if ((++_sp & 255u) == 0u) { if (xb_ld(&(bar)[XB_TMO])) break; if (_sp > XB_SPIN_CAP) { atomicAdd(&(bar)[XB_TMO], 1u); break; } } } } while (0)
struct XcdBarrier { unsigned* bar; unsigned x; volatile LAS unsigned* st; };
__device__ __forceinline__ XcdBarrier xcd_barrier_post(unsigned* bar, volatile LAS unsigned* st) {
    XcdBarrier b; b.bar = bar; b.x = xb_xcc_id(); b.st = st;
    if (threadIdx.x == 0) (void)xb_add(&bar[XB_XCNT(b.x)], 1u);
    return b;
}
__device__ __forceinline__ void xcd_barrier_complete(unsigned* bar, unsigned x, unsigned& nloc, unsigned& nx) {
    const unsigned G = gridDim.x * gridDim.y * gridDim.z;
    unsigned sum, cnt, mine, sp = 0u;
    for (;;) {
        sum = 0u; cnt = 0u; mine = 0u;
#pragma unroll
        for (unsigned j = 0; j < 16; ++j) { const unsigned c = xb_ld(&bar[XB_XCNT(j)]); sum += c; cnt += (c > 0u) ? 1u : 0u; mine = (j == x) ? c : mine; }
        if (sum == G) break;
        __builtin_amdgcn_s_sleep(1);
        if ((++sp & 255u) == 0u) { if (xb_ld(&bar[XB_TMO])) break; if (sp > XB_SPIN_CAP) { atomicAdd(&bar[XB_TMO], 1u); break; } }
    }
    nloc = mine > 0u ? mine : 1u; nx = cnt > 0u ? cnt : 1u;
}
__device__ __forceinline__ void xcd_barrier(const XcdBarrier& b) {
    asm volatile("s_waitcnt vmcnt(0)" ::: "memory");
    __syncthreads();
    if (threadIdx.x == 0) {
        unsigned* bar = b.bar;
        __builtin_amdgcn_s_waitcnt(0);
        unsigned nloc = b.st[0], nx = b.st[1];
        if (nloc == 0u) { xcd_barrier_complete(bar, b.x, nloc, nx); b.st[0] = nloc; b.st[1] = nx; }
        const unsigned old = xb_add(&bar[XB_XSUB(b.x)], 1u);
        const unsigned gen = old / nloc;
        if (old + 1u == (gen + 1u) * nloc) {
            __builtin_amdgcn_fence(__ATOMIC_RELEASE, "agent");
            asm volatile("s_waitcnt vmcnt(0)" ::: "memory");
            const unsigned og = xb_add(&bar[XB_TOP], 1u);
            const unsigned tg = og / nx;
            if (og + 1u == (tg + 1u) * nx) xb_add(&bar[XB_TOPGEN], 1u);
            else XB_SPIN(xb_ld(&bar[XB_TOPGEN]) == tg, bar);
            __builtin_amdgcn_fence(__ATOMIC_ACQUIRE, "agent");
            xb_add(&bar[XB_XGEN(b.x)], 1u);
            asm volatile("s_waitcnt vmcnt(0)" ::: "memory");
        } else {
            XB_SPIN(xb_ld(&bar[XB_XGEN(b.x)]) == gen, bar);
            __builtin_amdgcn_fence(__ATOMIC_ACQUIRE, "agent");
            asm volatile("s_waitcnt vmcnt(0)" ::: "memory");
        }
    }
    __syncthreads();
}

__global__ void __launch_bounds__(NTHREADS, 2) fwd_megakernel(Params P) {
    extern __shared__ __attribute__((aligned(16))) unsigned char lds_raw[];
    LAS unsigned char* lds = (LAS unsigned char*)lds_raw;
    cg::grid_group grid = cg::this_grid();
    const int tid = threadIdx.x, G = gridDim.x, bid = blockIdx.x;
    unsigned char* ws = P.ws;
    float* mod = (float*)(ws + WS_MOD);
    bf16_t* xmid = (bf16_t*)(ws + WS_S3);
    if (tid < 4) ((LAS unsigned*)(lds + LDS_BARW))[tid] = 0u;
    __syncthreads();
    const XcdBarrier xbar = xcd_barrier_post((unsigned*)(ws + WS_BAR), (volatile LAS unsigned*)(lds + LDS_BARW));
    if (P.ws == nullptr) grid.sync();

    for (int rep = 0; rep < REPS(0); ++rep) { phase0(P, lds); xcd_barrier(xbar); phase0_mod(P, lds); xcd_barrier(xbar); }
    phase_norm<0>(P.in[0], P.in[1], nullptr, P.in[10], mod, 0, 1024, (bf16_t*)(ws + WS_S0), nullptr);
    xcd_barrier(xbar);
    for (int rep = 0; rep < REPS(2); ++rep) {
        if (rep) xcd_barrier(xbar);
        pg8::Gemm g{(const bf16_t*)(ws + WS_S0), (const bf16_t*)(ws + WS_WIN), MT, DIN, 1024}; pg8::StaticOrder S; S.init(MT, DIN, G, bid);
        EpiIn E{(bf16_t*)(ws + WS_S1), (bf16_t*)(ws + WS_S2), (bf16_t*)(ws + WS_S3), (bf16_t*)(P.out + O_Y), (bf16_t*)(P.out + O_Y) + (size_t)MT * 1024, P.out};
        pg8::gemm_phase<EpiIn>(lds, g, S, E);
    }
    xcd_barrier(xbar);
    {
        const int vb = (G % 8 == 0) ? (bid % 8) * (G / 8) + bid / 8 : bid;
        { RgPre pre; if (vb < 2176) rglru_prefetch(P, vb, opaque_tid(), pre);
          for (int q = vb; q < 2176; q += G) rglru_task(P, lds, q, pre, (q + G < 2176) ? q + G : -1); }
        f32x2 w[31];
#pragma unroll
        for (int j = 0; j < 31; ++j) w[j] = *(const f32x2*)(P.in[12] + (size_t)j * 1024 + 2 * tid);
        const f32x2 bias = *(const f32x2*)(P.in[13] + 2 * tid);
        CfPre cpre;
        for (int rep = 0; rep < REPS(3); ++rep) {
        { const int q0 = (vb + G / 2) % G; conf_prefetch(P, (q0 >> 7) * 2048 + (q0 & 127) * 16, (q0 & 127) * 16, tid, cpre); }
        for (int q = (vb + G / 2) % G; q < 1152; q += G) {
            if (q < 1024) { const int b = q >> 7, t0 = (q & 127) * 16; const int qn = q + G;
                const int nr0 = (qn < 1024) ? (qn >> 7) * 2048 + (qn & 127) * 16 : -1, nt0 = (qn & 127) * 16;
                conf_task<16, true>(P, lds, b * 2048 + t0, t0, 0, false, w, bias, cpre, nr0, nt0); }
            else { const int sb = q - 1024; conf_task<8, false>(P, lds, MP + sb * 8, 0, sb, true, w, bias, cpre, -1, 0); }
        }
        }
    }
    xcd_barrier(xbar);
    for (int q = bid; q < 248; q += G) fix_task(P, lds, q);
    xcd_barrier(xbar);
    for (int rep = 0; rep < REPS(5); ++rep) {
        if (rep) xcd_barrier(xbar);
        pg8::StaticOrder S; S.init(MP, 1024, G, bid);
        { pg8::Gemm g{(const bf16_t*)(ws + WS_S0), (const bf16_t*)(ws + WS_WCA), MP, 1024, 1024};
          EpiMerge<0> E{(bf16_t*)(ws + WS_S1), (const bf16_t*)(P.out + O_Y)}; pg8::gemm_phase<EpiMerge<0>>(lds, g, S, E); }
        { pg8::Gemm g{(const bf16_t*)(ws + WS_S3), (const bf16_t*)(ws + WS_WRB), MP, 1024, 1280};
          EpiMerge<1> E{(bf16_t*)(ws + WS_S1), (const bf16_t*)(P.out + O_Y) + (size_t)MT * 1024}; pg8::gemm_phase<EpiMerge<1>>(lds, g, S, E); }
        {
            const int t2 = opaque_tid(), lane = t2 & 63, wave = t2 >> 6, fr = lane & 15, fq = lane >> 4;
            const bf16_t* sga = (const bf16_t*)(P.out + O_Y); const bf16_t* sgb = sga + (size_t)MT * 1024; bf16_t* mg = (bf16_t*)(ws + WS_S1);
            for (int t = bid; t < 256; t += G) {
                const int m0 = MP + (t >> 5) * 128, n0 = (t & 31) * 32;
                f32x4 a1[2] = {{0.f, 0.f, 0.f, 0.f}, {0.f, 0.f, 0.f, 0.f}}, a2[2] = {{0.f, 0.f, 0.f, 0.f}, {0.f, 0.f, 0.f, 0.f}};
                small_gemm<1024>(lds, (const bf16_t*)(ws + WS_S0), (const bf16_t*)(ws + WS_WCA), m0, n0, t2, a1);
                small_gemm<1280>(lds, (const bf16_t*)(ws + WS_S3), (const bf16_t*)(ws + WS_WRB), m0, n0, t2, a2);
#pragma unroll
                for (int ct = 0; ct < 2; ++ct) { const size_t off = (size_t)(m0 + wave * 16 + fr) * 1024 + n0 + ct * 16 + 4 * fq;
                    const u32x2 ga = *(const u32x2*)(sga + off), gb = *(const u32x2*)(sgb + off);
                    u32x2 o; o.x = pk_bf16(a1[ct][0] * bf_lo(ga.x) + a2[ct][0] * bf_lo(gb.x), a1[ct][1] * bf_hi(ga.x) + a2[ct][1] * bf_hi(gb.x));
                    o.y = pk_bf16(a1[ct][2] * bf_lo(ga.y) + a2[ct][2] * bf_lo(gb.y), a1[ct][3] * bf_hi(ga.y) + a2[ct][3] * bf_hi(gb.y));
                    *(u32x2*)(mg + off) = o; }
            }
        }
    }
    xcd_barrier(xbar);
    for (int rep = 0; rep < REPS(6); ++rep) {
        if (rep) xcd_barrier(xbar);
        pg8::Gemm g{(const bf16_t*)(ws + WS_S1), (const bf16_t*)(ws + WS_WO), MP, 1024, 1024}; pg8::StaticOrder S; S.init(MP, 1024, G, bid);
        EpiRes<false> E{P.in[0], xmid, mod, 2048}; pg8::gemm_phase<EpiRes<false>>(lds, g, S, E);
        {
            const int t2 = opaque_tid(), lane = t2 & 63, wave = t2 >> 6, fr = lane & 15, fq = lane >> 4;
            for (int t = bid; t < 256; t += G) {
                const int m0 = MP + (t >> 5) * 128, n0 = (t & 31) * 32;
                f32x4 a1[2] = {{0.f, 0.f, 0.f, 0.f}, {0.f, 0.f, 0.f, 0.f}};
                small_gemm<1024>(lds, (const bf16_t*)(ws + WS_S1), (const bf16_t*)(ws + WS_WO), m0, n0, t2, a1);
                const int r = m0 + wave * 16 + fr;
#pragma unroll
                for (int ct = 0; ct < 2; ++ct) { const int c = n0 + ct * 16 + 4 * fq;
                    const f32x4 xv = *(const f32x4*)(P.in[1] + (size_t)(r - MP) * 1024 + c), gv = *(const f32x4*)(mod + (size_t)batch_of_row(r) * NMOD + 2048 + c);
                    const f32x4 o = xv + gv * a1[ct]; u32x2 w; w.x = pk_bf16(o[0], o[1]); w.y = pk_bf16(o[2], o[3]);
                    *(u32x2*)(xmid + (size_t)r * 1024 + c) = w; }
            }
        }
    }
    xcd_barrier(xbar);
    phase_norm<1>(nullptr, nullptr, xmid, P.in[26], mod, 3072, 4096, (bf16_t*)(ws + WS_S0), nullptr);
    xcd_barrier(xbar);
    for (int rep = 0; rep < REPS(8); ++rep) {
        if (rep) xcd_barrier(xbar);
        pg8::Gemm g{(const bf16_t*)(ws + WS_S0), (const bf16_t*)(ws + WS_WUP), MT, 6144, 1024}; pg8::StaticOrder S; S.init(MT, 6144, G, bid);
        EpiUp E{(bf16_t*)(ws + WS_ACT), P.in[28], P.in[29], P.out + O_Y  , (float*)(ws + WS_UPA), (float*)(ws + WS_UPB), P.out, lds + LDS_STAGE};
        pg8::gemm_phase<EpiUp>(lds, g, S, E);
    }
    xcd_barrier(xbar);
    {
        const float* upa = (const float*)(ws + WS_UPA); const float* upb = (const float*)(ws + WS_UPB);
        const float* wdw = P.in[28]; const float* bdw = P.in[29];
        bf16_t* act = (bf16_t*)(ws + WS_ACT);
        for (int e = bid * NTHREADS + opaque_tid(); e < 56 * 2 * 3072; e += G * NTHREADS) {
            const int c = e % 3072, rr = (e / 3072) & 1, ti = e / 6144, pm = (ti / 7) * 8 + 1 + ti % 7;
            float cv[2];
#pragma unroll
            for (int bj = 0; bj < 2; ++bj) { const int col = bj * 3072 + c;
                const float a0 = upa[((size_t)pm * 2 + 0) * 6144 + col], a1 = upa[((size_t)pm * 2 + 1) * 6144 + col];
                const float b0 = upb[((size_t)(pm - 1) * 2 + 0) * 6144 + col], b1 = upb[((size_t)(pm - 1) * 2 + 1) * 6144 + col];
                const float cur = rr ? a1 : a0, p1 = rr ? a0 : b1, p2 = rr ? b1 : b0;
                cv[bj] = wdw[2 * 6144 + col] * cur + wdw[6144 + col] * p1 + wdw[col] * p2 + bdw[col]; }
            act[((size_t)pm * 256 + rr) * 3072 + c] = (bf16_t)(pk_bf16(gelu_tanh(cv[0]) * cv[1], 0.f) & 0xffffu);
        }
    }
    {
        const float* ups = P.out + O_Y; const float* stf = P.in[5];
        const float* wdw = P.in[28]; const float* bdw = P.in[29];
        bf16_t* act = (bf16_t*)(ws + WS_ACT);
        for (int e = bid * NTHREADS + opaque_tid(); e < MS * 768; e += G * NTHREADS) {
            const int c = (e % 768) * 4, s = e / 768, sb = s >> 3, t = s & 7;
            f32x4 cv[2];
#pragma unroll
            for (int bj = 0; bj < 2; ++bj) { const int col = bj * 3072 + c;
                const f32x4 cur = *(const f32x4*)(ups + (size_t)s * 6144 + col);
                const f32x4 p1 = *(const f32x4*)(t >= 1 ? ups + (size_t)(s - 1) * 6144 + col : stf + ((size_t)sb * 2 + 1) * 6144 + col);
                const f32x4 p2 = *(const f32x4*)(t >= 2 ? ups + (size_t)(s - 2) * 6144 + col : stf + ((size_t)sb * 2 + t) * 6144 + col);
                cv[bj] = *(const f32x4*)(wdw + 2 * 6144 + col) * cur + *(const f32x4*)(wdw + 6144 + col) * p1 + *(const f32x4*)(wdw + col) * p2 + *(const f32x4*)(bdw + col);
                if (t >= 6) *(f32x4*)(P.out + O_FFN_S + ((size_t)sb * 2 + t - 6) * 6144 + col) = cur; }
            u32x2 o; o.x = pk_bf16(gelu_tanh(cv[0][0]) * cv[1][0], gelu_tanh(cv[0][1]) * cv[1][1]); o.y = pk_bf16(gelu_tanh(cv[0][2]) * cv[1][2], gelu_tanh(cv[0][3]) * cv[1][3]);
            *(u32x2*)(act + ((size_t)MP + s) * 3072 + c) = o;
        }
    }
    xcd_barrier(xbar);
    {
        pg8::Gemm g{(const bf16_t*)(ws + WS_ACT), (const bf16_t*)(ws + WS_WDN), MP, 1024, 3072}; pg8::StaticOrder S; S.init(MP, 1024, G, bid);
        EpiRes<true> E{nullptr, xmid, mod, 5120}; pg8::gemm_phase<EpiRes<true>>(lds, g, S, E);
        {
            const int t2 = opaque_tid(), lane = t2 & 63, wave = t2 >> 6, fr = lane & 15, fq = lane >> 4;
            for (int t = bid; t < 256; t += G) {
                const int m0 = MP + (t >> 5) * 128, n0 = (t & 31) * 32;
                f32x4 a1[2] = {{0.f, 0.f, 0.f, 0.f}, {0.f, 0.f, 0.f, 0.f}};
                small_gemm<3072>(lds, (const bf16_t*)(ws + WS_ACT), (const bf16_t*)(ws + WS_WDN), m0, n0, t2, a1);
                const int r = m0 + wave * 16 + fr;
#pragma unroll
                for (int ct = 0; ct < 2; ++ct) { const int c = n0 + ct * 16 + 4 * fq;
                    bf16_t* xp = xmid + (size_t)r * 1024 + c;
                    const u32x2 xw = *(const u32x2*)xp; const f32x4 xv = {bf_lo(xw.x), bf_hi(xw.x), bf_lo(xw.y), bf_hi(xw.y)}, gv = *(const f32x4*)(mod + (size_t)batch_of_row(r) * NMOD + 5120 + c);
                    const f32x4 o = xv + gv * a1[ct]; u32x2 w; w.x = pk_bf16(o[0], o[1]); w.y = pk_bf16(o[2], o[3]);
                    *(u32x2*)xp = w; }
            }
        }
    }
    xcd_barrier(xbar);
    phase_norm<2>(nullptr, nullptr, xmid, P.in[31], nullptr, 0, 0, nullptr, P.out + O_Y);
}

extern "C" void kernel_launch(void* const* d_in, const int* in_sizes, int n_in, void* d_out, int out_size, void* d_ws, size_t ws_size, hipStream_t stream) {
    static int grid_blocks = 0;
    if (grid_blocks == 0) {
        if (n_in != 32 || (size_t)out_size != O_END || ws_size < WS_NEED) { fprintf(stderr, "kernel_launch: unexpected shapes: n_in %d out %d ws %zu (need %zu)\n", n_in, out_size, ws_size, (size_t)WS_NEED); grid_blocks = -1; return; }
        int dev = 0, cus = 0, per_cu = 0;
        hipGetDevice(&dev);
        hipDeviceGetAttribute(&cus, hipDeviceAttributeMultiprocessorCount, dev);
        if (hipFuncSetAttribute((const void*)fwd_megakernel, hipFuncAttributeMaxDynamicSharedMemorySize, LDS_BYTES) != hipSuccess) { fprintf(stderr, "kernel_launch: hipFuncSetAttribute failed\n"); grid_blocks = -1; return; }
        if (hipOccupancyMaxActiveBlocksPerMultiprocessor(&per_cu, (const void*)fwd_megakernel, NTHREADS, LDS_BYTES) != hipSuccess || per_cu < 1) { fprintf(stderr, "kernel_launch: occupancy query gave %d\n", per_cu); per_cu = 1; (void)hipGetLastError(); }
        grid_blocks = cus;
    }
    if (grid_blocks < 0) return;
    Params p{};
    for (int i = 0; i < 32; ++i) p.in[i] = (const float*)d_in[i];
    p.out = (float*)d_out; p.ws = (unsigned char*)d_ws;
    if (hipMemsetAsync((char*)d_ws + WS_BAR, 0, WS_BAR_BYTES, stream) != hipSuccess) { fprintf(stderr, "kernel_launch: memset of barrier words failed\n"); return; }
    void* args[] = {&p};
    hipError_t e = hipLaunchCooperativeKernel((const void*)fwd_megakernel, dim3(grid_blocks), dim3(NTHREADS), args, LDS_BYTES, stream);
    if (e != hipSuccess) fprintf(stderr, "cooperative launch failed: %s (grid %d)\n", hipGetErrorString(e), grid_blocks);
}
```

```cpp
#include <hip/hip_runtime.h>
#include <hip/hip_cooperative_groups.h>
#include <cstdio>
namespace cg = cooperative_groups;

#define LAS __attribute__((address_space(3)))
typedef unsigned short bf16_t;
typedef short bf16x8 __attribute__((ext_vector_type(8)));
typedef float f32x4 __attribute__((ext_vector_type(4)));
typedef float f32x2 __attribute__((ext_vector_type(2)));
typedef unsigned u32x4 __attribute__((ext_vector_type(4)));
typedef unsigned u32x2 __attribute__((ext_vector_type(2)));

constexpr int MP = 16384, MS = 1024, MT = MP + MS;
constexpr int DM = 1024, DC = 1024, DR = 1280, DFF = 3072, DIN = 6656, NMOD = 6144, NBATCH = 136;
constexpr int SEQ = 2048, DSEQ = 8;
constexpr float EPS = 1e-6f;
constexpr int NTHREADS = 512, NWAVES = 8;
#ifndef REP_PHASE
#define REP_PHASE -1
#endif
#define REPS(k) ((REP_PHASE == (k)) ? 2 : 1)

constexpr size_t A1K = (size_t)MT * 1024 * 2, A1280 = (size_t)MT * 1280 * 2;
constexpr size_t WS_WIN = 0;
constexpr size_t WS_WCA = WS_WIN + (size_t)DIN * 1024 * 2;
constexpr size_t WS_WRB = WS_WCA + (size_t)1024 * 1024 * 2;
constexpr size_t WS_WO  = WS_WRB + (size_t)1024 * 1280 * 2;
constexpr size_t WS_WUP = WS_WO + (size_t)1024 * 1024 * 2;
constexpr size_t WS_WDN = WS_WUP + (size_t)6144 * 1024 * 2;
constexpr size_t WS_WRG = WS_WDN + (size_t)1024 * 3072 * 2;
constexpr size_t WS_WIG = WS_WRG + (size_t)8 * 160 * 160 * 2;
constexpr size_t WS_MOD = WS_WIG + (size_t)8 * 160 * 160 * 2;
constexpr size_t WS_HL  = WS_MOD + (size_t)NBATCH * NMOD * 4;
constexpr size_t WS_PL  = WS_HL + (size_t)8 * 32 * 1280 * 4;
constexpr size_t WS_SP8 = WS_PL + (size_t)8 * 32 * 1280 * 4;
constexpr size_t WS_BAR = ((WS_SP8 + (size_t)1280 * 4 + 255) / 256) * 256;
constexpr size_t WS_BAR_BYTES = 3456 * 4;
constexpr size_t WS_SCH = ((WS_BAR + WS_BAR_BYTES + 255) / 256) * 256;
constexpr size_t WS_SCL = WS_SCH + (size_t)144 * 1024 * 2;
constexpr size_t WS_S0  = ((WS_SCL + (size_t)144 * 1024 * 2 + 4095) / 4096) * 4096;
constexpr size_t WS_S3  = WS_S0 + A1K;
constexpr size_t WS_S1  = WS_S3 + A1280;
constexpr size_t WS_S2  = WS_S1 + A1K;
constexpr size_t WS_S4  = WS_S2 + A1280;
constexpr size_t WS_ACT = WS_S1;
constexpr size_t WS_UPA = WS_ACT + (size_t)MT * 3072 * 2;
constexpr size_t WS_UPB = WS_UPA + (size_t)68 * 2 * 6144 * 4;
constexpr size_t WS_END0 = WS_S4 + A1280;
constexpr size_t WS_END1 = WS_UPB + (size_t)68 * 2 * 6144 * 4;
static_assert(WS_END1 <= WS_END0, "act + side buffers must fit in S1..S4");
constexpr size_t WS_UPS = WS_S3;
static_assert((size_t)MS * 6144 * 4 <= A1280, "ups fits S3");
constexpr size_t WS_NEED = WS_END0;
static_assert(WS_NEED <= (size_t)256 * 1024 * 1024, "workspace budget");

constexpr size_t O_Y = 0;
constexpr size_t O_CONF_P = (size_t)MT * 1024;
constexpr size_t O_RCONV_P = O_CONF_P + (size_t)8 * 30 * 1024;
constexpr size_t O_H_P = O_RCONV_P + (size_t)8 * 3 * 1280;
constexpr size_t O_FFN_P = O_H_P + (size_t)8 * 1280;
constexpr size_t O_CONF_S = O_FFN_P + (size_t)8 * 2 * 6144;
constexpr size_t O_RCONV_S = O_CONF_S + (size_t)128 * 30 * 1024;
constexpr size_t O_H_S = O_RCONV_S + (size_t)128 * 3 * 1280;
constexpr size_t O_FFN_S = O_H_S + (size_t)128 * 1280;
constexpr size_t O_END = O_FFN_S + (size_t)128 * 2 * 6144;

constexpr int LDS_STAGE = 131072, LDS_EXCH = 8192, LDS_CW = LDS_STAGE + LDS_EXCH, LDS_BARW = LDS_CW + 4096, LDS_BYTES = LDS_BARW + 16;

struct Params { const float* in[32]; float* out; unsigned char* ws; };

typedef __bf16 bf16x2_t __attribute__((ext_vector_type(2)));
__device__ __forceinline__ unsigned pk_bf16(float lo, float hi) { const f32x2 v = {lo, hi}; const bf16x2_t b = __builtin_convertvector(v, bf16x2_t); return __builtin_bit_cast(unsigned, b); }
__device__ __forceinline__ float bf_lo(unsigned w) { return __uint_as_float(w << 16); }
__device__ __forceinline__ float bf_hi(unsigned w) { return __uint_as_float(w & 0xffff0000u); }
__device__ __forceinline__ float sigmoidf_(float x) { return __builtin_amdgcn_rcpf(1.0f + __expf(-x)); }
__device__ __forceinline__ float siluf_(float x) { return x * sigmoidf_(x); }
__device__ __forceinline__ float gelu_tanh(float x) { const float u = 1.5957691216057308f * (x + 0.044715f * x * x * x); return x * sigmoidf_(u); }
__device__ __forceinline__ f32x2 sigmoid2(f32x2 x) { const f32x2 t = x * (-1.4426950408889634f); f32x2 e; e.x = __builtin_amdgcn_exp2f(t.x); e.y = __builtin_amdgcn_exp2f(t.y);
    const f32x2 d = e + 1.0f; f32x2 r; r.x = __builtin_amdgcn_rcpf(d.x); r.y = __builtin_amdgcn_rcpf(d.y); return r; }
__device__ __forceinline__ f32x2 gelu2(f32x2 x) {
    const f32x2 t = x * ((x * x) * (-0.10294324f) + (-2.3022082f)); f32x2 e; e.x = __builtin_amdgcn_exp2f(t.x); e.y = __builtin_amdgcn_exp2f(t.y);
    const f32x2 d = e + 1.0f; f32x2 r; r.x = __builtin_amdgcn_rcpf(d.x); r.y = __builtin_amdgcn_rcpf(d.y); return x * r; }
__device__ __forceinline__ float wave_sum(float v) {
#pragma unroll
    for (int o = 1; o < 64; o <<= 1) v += __shfl_xor(v, o);
    return v;
}
__device__ __forceinline__ int batch_of_row(int r) { return r < MP ? (r >> 11) : 8 + ((r - MP) >> 3); }
__device__ __forceinline__ int opaque_tid() { int t = threadIdx.x; asm volatile("" : "+v"(t)); return t; }
#define LDS_FENCE() asm volatile("s_waitcnt lgkmcnt(0)" ::: "memory")

namespace pg8 {
constexpr int BM = 256, BK = 64, HALF = 128, HTB = HALF * BK * 2, STAGE_BYTES = 8 * HTB, NXCD = 8, WGM = 8;
__host__ __device__ __forceinline__ int lds_byte(int r, int c) { const int st = (r >> 4) * 2 + (c >> 5), rr = r & 15, cc = c & 31, ob = rr * 64 + cc * 2; return st * 1024 + (ob ^ (((ob >> 9) & 1) << 5)); }
__host__ __device__ __forceinline__ void stage_rc(int b, int& R, int& C) { const int st = b / 1024, sb = b % 1024, swz = sb ^ (((sb >> 9) & 1) << 5); R = (st >> 1) * 16 + swz / 64; C = (st & 1) * 32 + (swz % 64) / 2; }
__host__ __device__ __forceinline__ int perm32(int rho) { const int n = rho >> 4, i = rho & 15; return 8 * (i >> 2) + 4 * n + (i & 3); }
struct Unit { int pm, pn; };
struct Gemm { const bf16_t* A; const bf16_t* Bt; int M, N, K; };
struct StaticOrder {
    int nM, nN, nwg, G, c;
    __device__ void init(int M, int N, int G_, int c_) { nM = M / BM; nN = N / BM; nwg = nM * nN; G = G_; c = c_; }
    __device__ bool next(int i, Unit& u) const {
        const long L = (long)i * G + c; if (L >= nwg) return false;
        int wgid = (int)L; { const int q = nwg / NXCD, r = nwg % NXCD, xcd = wgid % NXCD, off = wgid / NXCD; wgid = (xcd < r ? xcd * (q + 1) : r * (q + 1) + (xcd - r) * q) + off; }
        const int nig = WGM * nN, gid = wgid / nig, fm = gid * WGM, gsz = (nM - fm) < WGM ? (nM - fm) : WGM;
        u.pm = fm + ((wgid % nig) % gsz); u.pn = (wgid % nig) / gsz; return true;
    }
};

template <class Epi>
__device__ __forceinline__ void gemm_phase(LAS unsigned char* lds, const Gemm g, const StaticOrder& S, const Epi& E) {
    int tid_ = threadIdx.x; asm volatile("" : "+v"(tid_));
    const int tid = tid_, wid = __builtin_amdgcn_readfirstlane(tid >> 6), lane = tid & 63, wr = wid >> 2, wc = wid & 3, fr = lane & 15, fq = lane >> 4;
    const int K = g.K, nt = K / BK;
    unsigned voffA[2], voffB[2];
#pragma unroll
    for (int i = 0; i < 2; ++i) { int R, C; stage_rc(tid * 16 + i * 8192, R, C); const int Rb = Epi::PERM ? ((R >> 5) * 64 + perm32(R & 31)) : R;
        voffA[i] = (unsigned)(R * K + C) * 2u; voffB[i] = (unsigned)(Rb * K + C) * 2u; }
    const size_t kstep = (size_t)(BK * 2);
    const size_t hstep = (size_t)HALF * K * 2;
    const size_t tstep = 2 * hstep;
    const size_t hstepB = Epi::PERM ? (size_t)32 * K * 2 : hstep;
    const unsigned ldsw = (unsigned)wid * 1024u;
    const int aoff = lds_byte(wr * 64 + fr, fq * 8), boff = lds_byte(wc * 32 + fr, fq * 8);
#define PG8_SA(b, h) (((b) * 2 + (h)) * HTB)
#define PG8_SB(b, h) ((4 + (b) * 2 + (h)) * HTB)
#define PG8_STAGE(bufoff, gbase, voff) do { _Pragma("unroll") for (int _i = 0; _i < 2; ++_i) \
        __builtin_amdgcn_global_load_lds((const unsigned*)((const char*)(gbase) + (voff)[_i]), (LAS unsigned*)(lds + (bufoff) + ldsw + _i * 8192), 16, 0, 0); } while (0)
#define PG8_LDA(dst, b, h) do { _Pragma("unroll") for (int m = 0; m < 4; ++m) _Pragma("unroll") for (int k = 0; k < 2; ++k) dst[m][k] = *(const LAS bf16x8*)(lds + PG8_SA(b, h) + aoff + m * 2048 + k * 1024); } while (0)
#define PG8_LDB(dst, b, h) do { _Pragma("unroll") for (int n = 0; n < 2; ++n) _Pragma("unroll") for (int k = 0; k < 2; ++k) dst[n][k] = *(const LAS bf16x8*)(lds + PG8_SB(b, h) + boff + n * 2048 + k * 1024); } while (0)
#define PG8_MMA(ai, bj, At, Bt) do { __builtin_amdgcn_s_setprio(1); _Pragma("unroll") for (int m = 0; m < 4; ++m) _Pragma("unroll") for (int n = 0; n < 2; ++n) _Pragma("unroll") for (int k = 0; k < 2; ++k) \
        acc[ai][bj][m][n] = __builtin_amdgcn_mfma_f32_16x16x32_bf16(Bt[n][k], At[m][k], acc[ai][bj][m][n], 0, 0, 0); __builtin_amdgcn_s_setprio(0); } while (0)
#define PG8_WAIT_V(n) asm volatile("s_waitcnt vmcnt(" #n ")" ::: "memory")
#define PG8_WAIT_L(n) asm volatile("s_waitcnt lgkmcnt(" #n ")" ::: "memory")
#define PG8_BAR __builtin_amdgcn_s_barrier()
#define PG8_SCHED __builtin_amdgcn_sched_barrier(0)
    Unit cur, nxt; int ui = 0;
    if (!S.next(0, cur)) return;
    f32x4 acc[2][2][4][2];
#pragma unroll
    for (int a = 0; a < 2; ++a)
#pragma unroll
        for (int b = 0; b < 2; ++b)
#pragma unroll
            for (int m = 0; m < 4; ++m)
#pragma unroll
                for (int n = 0; n < 2; ++n) acc[a][b][m][n] = (f32x4){0.f, 0.f, 0.f, 0.f};
    bf16x8 At[4][2], B0[2][2], B1[2][2];
    const char* cA = (const char*)g.A + (size_t)cur.pm * tstep; const char* cB = (const char*)g.Bt + (size_t)cur.pn * tstep;
    PG8_STAGE(PG8_SB(0, 0), cB, voffB); PG8_STAGE(PG8_SA(0, 0), cA, voffA); PG8_STAGE(PG8_SB(0, 1), cB + hstepB, voffB); PG8_STAGE(PG8_SA(0, 1), cA + hstep, voffA);
    if (wr == 1) PG8_BAR;
    PG8_WAIT_V(4); PG8_BAR;
    PG8_STAGE(PG8_SB(1, 0), cB + kstep, voffB); PG8_STAGE(PG8_SA(1, 0), cA + kstep, voffA); PG8_STAGE(PG8_SB(1, 1), cB + hstepB + kstep, voffB);
    PG8_WAIT_V(6); PG8_BAR;
    for (;;) {
        const bool has_next = S.next(ui + 1, nxt);
        const char* nA = has_next ? (const char*)g.A + (size_t)nxt.pm * tstep : cA; const char* nB = has_next ? (const char*)g.Bt + (size_t)nxt.pn * tstep : cB;
        for (int t = 0; t < nt; t += 2) {
            const bool last = (t == nt - 2);
            const char* a1 = cA + (size_t)(t + 1) * kstep;
            const char* a2 = last ? nA : cA + (size_t)(t + 2) * kstep; const char* b2 = last ? nB : cB + (size_t)(t + 2) * kstep;
            const char* a3 = a2 + kstep; const char* b3 = b2 + kstep;
            PG8_LDB(B0, 0, 0); PG8_SCHED; PG8_LDA(At, 0, 0); PG8_STAGE(PG8_SA(1, 1), a1 + hstep, voffA);
            PG8_WAIT_L(8); PG8_BAR; PG8_WAIT_L(0); PG8_MMA(0, 0, At, B0); PG8_BAR; PG8_SCHED;
            PG8_LDB(B1, 0, 1); PG8_STAGE(PG8_SB(0, 0), b2, voffB);
            PG8_BAR; PG8_WAIT_L(0); PG8_MMA(0, 1, At, B1); PG8_BAR;
            PG8_LDA(At, 0, 1); PG8_STAGE(PG8_SA(0, 0), a2, voffA);
            PG8_BAR; PG8_WAIT_L(0); PG8_MMA(1, 0, At, B0); PG8_BAR; PG8_SCHED;
            PG8_STAGE(PG8_SB(0, 1), b2 + hstepB, voffB);
            PG8_WAIT_V(6); PG8_BAR; PG8_MMA(1, 1, At, B1); PG8_BAR;
            PG8_LDB(B0, 1, 0); PG8_SCHED; PG8_LDA(At, 1, 0); PG8_STAGE(PG8_SA(0, 1), a2 + hstep, voffA);
            PG8_WAIT_L(8); PG8_BAR; PG8_WAIT_L(0); PG8_MMA(0, 0, At, B0); PG8_BAR; PG8_SCHED;
            PG8_LDB(B1, 1, 1); PG8_STAGE(PG8_SB(1, 0), b3, voffB);
            PG8_BAR; PG8_WAIT_L(0); PG8_MMA(0, 1, At, B1); PG8_BAR;
            PG8_LDA(At, 1, 1); PG8_STAGE(PG8_SA(1, 0), a3, voffA);
            PG8_BAR; PG8_WAIT_L(0); PG8_MMA(1, 0, At, B0); PG8_BAR; PG8_SCHED;
            PG8_STAGE(PG8_SB(1, 1), b3 + hstepB, voffB);
            PG8_WAIT_V(6); PG8_BAR; PG8_MMA(1, 1, At, B1); PG8_BAR;
        }
        { int e_fr = fr, e_fq = fq, e_wr = wr, e_wc = wc; asm volatile("" : "+v"(e_fr), "+v"(e_fq), "+s"(e_wr), "+s"(e_wc));
          E(acc, cur, e_wr, e_wc, e_fr, e_fq); }
        if (!has_next) break;
#pragma unroll
        for (int a = 0; a < 2; ++a)
#pragma unroll
            for (int b = 0; b < 2; ++b)
#pragma unroll
                for (int m = 0; m < 4; ++m)
#pragma unroll
                    for (int n = 0; n < 2; ++n) acc[a][b][m][n] = (f32x4){0.f, 0.f, 0.f, 0.f};
        cur = nxt; cA = nA; cB = nB; ++ui;
    }
    PG8_WAIT_V(0);
    if (wr == 0) PG8_BAR;
    PG8_BAR;
#undef PG8_SA
#undef PG8_SB
#undef PG8_STAGE
#undef PG8_LDA
#undef PG8_LDB
#undef PG8_MMA
#undef PG8_WAIT_V
#undef PG8_WAIT_L
#undef PG8_SCHED
}
}
using pg8::Unit;

typedef const f32x4 (&AccRef)[2][2][4][2];

struct EpiIn {
    static constexpr bool PERM = true;
    bf16_t *uglu, *rnnx, *gg, *sga, *sgb; float* out;
    __device__ __forceinline__ void operator()(AccRef acc, const Unit& u, int wr, int wc, int fr, int fq) const {
        const int row0 = u.pm * 256 + wr * 64 + fr, cl = wc * 32 + 8 * fq;
        if (u.pn < 8) {
            const int col = u.pn * 128 + cl;
#pragma unroll
            for (int ai = 0; ai < 2; ++ai)
#pragma unroll
                for (int m = 0; m < 4; ++m) {
                    const int r = row0 + ai * 128 + m * 16;
                    f32x4 o[2];
#pragma unroll
                    for (int n = 0; n < 2; ++n)
#pragma unroll
                        for (int jp = 0; jp < 2; ++jp) { const f32x2 vv = {acc[ai][0][m][n][2 * jp], acc[ai][0][m][n][2 * jp + 1]}, gg2 = {acc[ai][1][m][n][2 * jp], acc[ai][1][m][n][2 * jp + 1]};
                            const f32x2 r = vv * sigmoid2(gg2); o[n][2 * jp] = r.x; o[n][2 * jp + 1] = r.y; }
                    u32x4 w; w.x = pk_bf16(o[0][0], o[0][1]); w.y = pk_bf16(o[0][2], o[0][3]); w.z = pk_bf16(o[1][0], o[1][1]); w.w = pk_bf16(o[1][2], o[1][3]);
                    *(u32x4*)(uglu + (size_t)r * 1024 + col) = w;
                    float* so = nullptr;
                    if (r < MP) { const int t = r & 2047; if (t >= 2018) so = out + O_CONF_P + ((size_t)(r >> 11) * 30 + (t - 2018)) * 1024 + col; }
                    else { const int s = r - MP; so = out + O_CONF_S + ((size_t)(s >> 3) * 30 + 22 + (s & 7)) * 1024 + col; }
                    if (so) { *(f32x4*)so = o[0]; *(f32x4*)(so + 4) = o[1]; }
                }
        } else if (u.pn < 13) {
#pragma unroll
            for (int ai = 0; ai < 2; ++ai)
#pragma unroll
                for (int m = 0; m < 4; ++m) {
                    const int r = row0 + ai * 128 + m * 16;
                    float* so = nullptr;
                    if (r < MP) { const int t = r & 2047; if (t >= 2045) so = out + O_RCONV_P + ((size_t)(r >> 11) * 3 + (t - 2045)) * 1280; }
                    else { const int s = r - MP; if ((s & 7) >= 5) so = out + O_RCONV_S + ((size_t)(s >> 3) * 3 + (s & 7) - 5) * 1280; }
#pragma unroll
                    for (int bj = 0; bj < 2; ++bj) {
                        const int col = (u.pn - 8) * 256 + wc * 64 + bj * 32 + 8 * fq;
                        const f32x4 v0 = acc[ai][bj][m][0], v1 = acc[ai][bj][m][1];
                        u32x4 w; w.x = pk_bf16(v0[0], v0[1]); w.y = pk_bf16(v0[2], v0[3]); w.z = pk_bf16(v1[0], v1[1]); w.w = pk_bf16(v1[2], v1[3]);
                        *(u32x4*)(rnnx + (size_t)r * 1280 + col) = w;
                        if (so) { *(f32x4*)(so + col) = v0; *(f32x4*)(so + col + 4) = v1; }
                    }
                }
        } else if (u.pn < 18) { act_store<true>(acc, gg, 1280, (u.pn - 13) * 256 + wc * 64 + 8 * fq, row0); }
        else if (u.pn < 22) { act_store<false>(acc, sga, 1024, (u.pn - 18) * 256 + wc * 64 + 8 * fq, row0); }
        else { act_store<false>(acc, sgb, 1024, (u.pn - 22) * 256 + wc * 64 + 8 * fq, row0); }
    }
    template <bool ISG> __device__ __forceinline__ void act_store(AccRef acc, bf16_t* dst, int ld, int c0, int row0) const {
#pragma unroll
        for (int ai = 0; ai < 2; ++ai)
#pragma unroll
            for (int m = 0; m < 4; ++m) {
                const int r = row0 + ai * 128 + m * 16;
#pragma unroll
                for (int bj = 0; bj < 2; ++bj) {
                    f32x4 v0 = acc[ai][bj][m][0], v1 = acc[ai][bj][m][1];
#pragma unroll
                    for (int jp = 0; jp < 2; ++jp) { const f32x2 a = {v0[2 * jp], v0[2 * jp + 1]}, b = {v1[2 * jp], v1[2 * jp + 1]};
                        const f32x2 ra = ISG ? gelu2(a) : sigmoid2(a), rb = ISG ? gelu2(b) : sigmoid2(b);
                        v0[2 * jp] = ra.x; v0[2 * jp + 1] = ra.y; v1[2 * jp] = rb.x; v1[2 * jp + 1] = rb.y; }
                    u32x4 w; w.x = pk_bf16(v0[0], v0[1]); w.y = pk_bf16(v0[2], v0[3]); w.z = pk_bf16(v1[0], v1[1]); w.w = pk_bf16(v1[2], v1[3]);
                    *(u32x4*)(dst + (size_t)r * ld + c0 + bj * 32) = w;
                }
            }
    }
};

template <int MODE> struct EpiMerge {
    static constexpr bool PERM = true;
    bf16_t* T; const bf16_t* gate;
    __device__ __forceinline__ void operator()(AccRef acc, const Unit& u, int wr, int wc, int fr, int fq) const {
        const int row0 = u.pm * 256 + wr * 64 + fr, col0 = u.pn * 256 + wc * 64 + 8 * fq;
#pragma unroll
        for (int ai = 0; ai < 2; ++ai)
#pragma unroll
            for (int m = 0; m < 4; ++m) {
                const size_t rb = (size_t)(row0 + ai * 128 + m * 16) * 1024;
#pragma unroll
                for (int bj = 0; bj < 2; ++bj) {
                    const size_t off = rb + col0 + bj * 32;
                    const u32x4 gw = *(const u32x4*)(gate + off);
                    const f32x4 v0 = acc[ai][bj][m][0], v1 = acc[ai][bj][m][1];
                    float o[8];
                    o[0] = v0[0] * bf_lo(gw.x); o[1] = v0[1] * bf_hi(gw.x); o[2] = v0[2] * bf_lo(gw.y); o[3] = v0[3] * bf_hi(gw.y);
                    o[4] = v1[0] * bf_lo(gw.z); o[5] = v1[1] * bf_hi(gw.z); o[6] = v1[2] * bf_lo(gw.w); o[7] = v1[3] * bf_hi(gw.w);
                    if (MODE == 1) { const u32x4 tw = *(const u32x4*)(T + off);
                        o[0] += bf_lo(tw.x); o[1] += bf_hi(tw.x); o[2] += bf_lo(tw.y); o[3] += bf_hi(tw.y); o[4] += bf_lo(tw.z); o[5] += bf_hi(tw.z); o[6] += bf_lo(tw.w); o[7] += bf_hi(tw.w); }
                    u32x4 w; w.x = pk_bf16(o[0], o[1]); w.y = pk_bf16(o[2], o[3]); w.z = pk_bf16(o[4], o[5]); w.w = pk_bf16(o[6], o[7]);
                    *(u32x4*)(T + off) = w;
                }
            }
    }
};

template <bool INPLACE> struct EpiRes {
    static constexpr bool PERM = true;
    const float* xp; bf16_t* xb; const float* mod; int goff;
    __device__ __forceinline__ void operator()(AccRef acc, const Unit& u, int wr, int wc, int fr, int fq) const {
        const int row0 = u.pm * 256 + wr * 64 + fr, col0 = u.pn * 256 + wc * 64 + 8 * fq;
#pragma unroll
        for (int ai = 0; ai < 2; ++ai)
#pragma unroll
            for (int m = 0; m < 4; ++m) {
                const int r = row0 + ai * 128 + m * 16;
                const float* gp = mod + (size_t)(r >> 11) * NMOD + goff;
#pragma unroll
                for (int bj = 0; bj < 2; ++bj) {
                    const int c = col0 + bj * 32;
                    const f32x4 g0 = *(const f32x4*)(gp + c), g1 = *(const f32x4*)(gp + c + 4);
                    f32x4 x0, x1;
                    if (!INPLACE) { x0 = *(const f32x4*)(xp + (size_t)r * 1024 + c); x1 = *(const f32x4*)(xp + (size_t)r * 1024 + c + 4); }
                    else { const u32x4 w = *(const u32x4*)(xb + (size_t)r * 1024 + c); x0 = (f32x4){bf_lo(w.x), bf_hi(w.x), bf_lo(w.y), bf_hi(w.y)}; x1 = (f32x4){bf_lo(w.z), bf_hi(w.z), bf_lo(w.w), bf_hi(w.w)}; }
                    x0 = x0 + g0 * acc[ai][bj][m][0]; x1 = x1 + g1 * acc[ai][bj][m][1];
                    u32x4 o; o.x = pk_bf16(x0[0], x0[1]); o.y = pk_bf16(x0[2], x0[3]); o.z = pk_bf16(x1[0], x1[1]); o.w = pk_bf16(x1[2], x1[3]);
                    *(u32x4*)(xb + (size_t)r * 1024 + c) = o;
                }
            }
    }
};

struct EpiUp {
    static constexpr bool PERM = true;
    bf16_t* act; const float* wdw; const float* bdw; float* ups; float* upa; float* upb; float* out; LAS unsigned char* exch;
    template <int CTRL> static __device__ __forceinline__ float dpp_keep(float old, float src) {
        return __builtin_bit_cast(float, __builtin_amdgcn_update_dpp(__builtin_bit_cast(int, old), __builtin_bit_cast(int, src), CTRL, 0xf, 0xf, false)); }
    __device__ __forceinline__ void conv_prompt(AccRef acc, const Unit& u, int wr, int wc, int fr, int fq) const {
        const int cl = wc * 32 + 8 * fq;
#pragma unroll
        for (int ai = 0; ai < 2; ++ai) {
            const int slab = 2 * ai + wr;
            const int rowb = u.pm * 256 + ai * 128 + wr * 64 + fr;
#pragma unroll
            for (int n = 0; n < 2; ++n)
#pragma unroll
            for (int jp = 0; jp < 2; ++jp) {
                float gq[4][2];
                int clx = cl;
#pragma unroll
                for (int bj = 0; bj < 2; ++bj) {
                    asm volatile("" : "+v"(clx));
                    const int col = bj * 3072 + u.pn * 128 + clx + 4 * n + 2 * jp;
                    const LAS float* cwp = (const LAS float*)(exch + LDS_EXCH) + bj * 128 + clx + 4 * n + 2 * jp;
                    const f32x2 W0 = *(const LAS f32x2*)cwp, W1 = *(const LAS f32x2*)(cwp + 256), W2 = *(const LAS f32x2*)(cwp + 512), BB = *(const LAS f32x2*)(cwp + 768);
                    f32x2 X1 = {0.f, 0.f}, X2 = {0.f, 0.f};
                    if (slab > 0) {
                        X1 = *(const LAS f32x2*)(exch + (size_t)(((((slab - 1) * 2 + 1) * 2 + bj) * 128 + clx + 4 * n + 2 * jp) * 4));
                        X2 = *(const LAS f32x2*)(exch + (size_t)(((((slab - 1) * 2 + 0) * 2 + bj) * 128 + clx + 4 * n + 2 * jp) * 4));
                    }
#pragma unroll
                    for (int jj = 0; jj < 2; ++jj) {
#pragma unroll
                        for (int m = 0; m < 4; ++m) {
                            const float cur = acc[ai][bj][m][n][2 * jp + jj];
                            float t1, t2;
                            if (m == 0) { t1 = X1[jj]; t2 = (fr == 0) ? X2[jj] : X1[jj]; }
                            else { const float prv = acc[ai][bj][m > 0 ? m - 1 : 0][n][2 * jp + jj]; t1 = dpp_keep<0x10F>(0.f, prv); t2 = dpp_keep<0x10E>(0.f, prv); }
                            const float p1 = dpp_keep<0x111>(t1, cur);
                            const float p2 = dpp_keep<0x112>(t2, cur);
                            const float cv = W2[jj] * cur + W1[jj] * p1 + W0[jj] * p2 + BB[jj];
                            if (bj == 0) gq[m][jj] = gelu_tanh(cv); else gq[m][jj] *= cv;
                        }
                    }
                    __builtin_amdgcn_sched_barrier(0);
                }
#pragma unroll
                for (int m = 0; m < 4; ++m)
                    *(unsigned*)(act + (size_t)(rowb + 16 * m) * 3072 + u.pn * 128 + clx + 4 * n + 2 * jp) = pk_bf16(gq[m][0], gq[m][1]);
                __builtin_amdgcn_sched_barrier(0);
            }
        }
    }
    __device__ __forceinline__ void operator()(AccRef acc, const Unit& u, int wr, int wc, int fr, int fq) const {
        const int cl = wc * 32 + 8 * fq;
        if (u.pm >= 64) {
#pragma unroll
            for (int ai = 0; ai < 2; ++ai)
#pragma unroll
                for (int m = 0; m < 4; ++m) {
                    float* dst = ups + (size_t)((u.pm - 64) * 256 + ai * 128 + wr * 64 + m * 16 + fr) * 6144 + u.pn * 128 + cl;
#pragma unroll
                    for (int bj = 0; bj < 2; ++bj)
#pragma unroll
                        for (int n = 0; n < 2; ++n) *(f32x4*)(dst + bj * 3072 + 4 * n) = acc[ai][bj][m][n];
                }
            __builtin_amdgcn_s_barrier(); __builtin_amdgcn_s_barrier();
            return;
        }
        f32x2 cwv; LAS f32x2* cwd;
        {
            const int t = (wr * 4 + wc) * 64 + fq * 16 + fr;
            const int k = t >> 7, rem = (t & 127) * 2, bj = rem >> 7, c2 = rem & 127;
            const float* srcp = (k < 3 ? wdw + (size_t)k * 6144 : bdw) + bj * 3072 + u.pn * 128 + c2;
            cwv = *(const f32x2*)srcp; cwd = (LAS f32x2*)((LAS float*)(exch + LDS_EXCH) + k * 256 + bj * 128 + c2);
        }
        if (fr >= 14) {
#pragma unroll
            for (int ai = 0; ai < 2; ++ai)
#pragma unroll
                for (int bj = 0; bj < 2; ++bj)
#pragma unroll
                    for (int n = 0; n < 2; ++n)
                        *(LAS f32x4*)(exch + (size_t)(((((2 * ai + wr) * 2 + (fr - 14)) * 2 + bj) * 128 + cl + 4 * n) * 4)) = acc[ai][bj][3][n];
        }
        if (wr == 0 && fr < 2) {
#pragma unroll
            for (int bj = 0; bj < 2; ++bj)
#pragma unroll
                for (int n = 0; n < 2; ++n) *(f32x4*)(upa + ((size_t)(u.pm * 2 + fr)) * 6144 + bj * 3072 + u.pn * 128 + cl + 4 * n) = acc[0][bj][0][n];
        }
        if (wr == 1 && fr >= 14) {
#pragma unroll
            for (int bj = 0; bj < 2; ++bj)
#pragma unroll
                for (int n = 0; n < 2; ++n) {
                    *(f32x4*)(upb + ((size_t)(u.pm * 2 + fr - 14)) * 6144 + bj * 3072 + u.pn * 128 + cl + 4 * n) = acc[1][bj][3][n];
                    if ((u.pm & 7) == 7) *(f32x4*)(out + O_FFN_P + ((size_t)((u.pm >> 3) * 2 + fr - 14)) * 6144 + bj * 3072 + u.pn * 128 + cl + 4 * n) = acc[1][bj][3][n];
                }
        }
        *cwd = cwv;
        asm volatile("s_waitcnt lgkmcnt(0)" ::: "memory");
        __builtin_amdgcn_s_barrier(); __builtin_amdgcn_s_barrier();
        asm volatile("" ::: "memory");
        conv_prompt(acc, u, wr, wc, fr, fq);
    }
};

__device__ __forceinline__ void transpose_item(const float* W, int K, int N, bf16_t* WT, int k0, int n0, int nd0, LAS float* scr, int lane) {
#pragma unroll 8
    for (int i = 0; i < 32; ++i) { const int kk = 2 * i + (lane >> 5); scr[kk * 33 + (lane & 31)] = W[(size_t)(k0 + kk) * N + n0 + (lane & 31)]; }
    LDS_FENCE();
    const int c = lane & 7;
#pragma unroll
    for (int j = 0; j < 4; ++j) { const int n = (lane >> 3) + 8 * j; const LAS float* s = scr + (8 * c) * 33 + n;
        u32x4 o; o.x = pk_bf16(s[0 * 33], s[1 * 33]); o.y = pk_bf16(s[2 * 33], s[3 * 33]); o.z = pk_bf16(s[4 * 33], s[5 * 33]); o.w = pk_bf16(s[6 * 33], s[7 * 33]);
        *(u32x4*)(WT + (size_t)(nd0 + n) * K + k0 + 8 * c) = o; }
    LDS_FENCE();
}
__device__ __forceinline__ int perm_in(int n) { if (n >= 2048) return n; const int bj = n >> 10, rem = n & 1023, c = rem & 127; return 256 * (rem >> 7) + (c >> 5) * 64 + bj * 32 + (c & 31); }
__device__ __forceinline__ int perm_up(int n) { const int bj = n >= 3072 ? 1 : 0, rem = n - bj * 3072, c = rem & 127; return 256 * (rem >> 7) + (c >> 5) * 64 + bj * 32 + (c & 31); }

__device__ __forceinline__ void split8(const float (&v)[8], bf16x8& hi, bf16x8& lo) {
    unsigned h[4], l[4];
#pragma unroll
    for (int i = 0; i < 4; ++i) { h[i] = pk_bf16(v[2 * i], v[2 * i + 1]); l[i] = pk_bf16(v[2 * i] - bf_lo(h[i]), v[2 * i + 1] - bf_hi(h[i])); }
    u32x4 H = {h[0], h[1], h[2], h[3]}, L = {l[0], l[1], l[2], l[3]};
    hi = __builtin_bit_cast(bf16x8, H); lo = __builtin_bit_cast(bf16x8, L);
}

__device__ __forceinline__ void phase0(const Params& P, LAS unsigned char* lds) {
    const int tid = opaque_tid(), lane = tid & 63, wave = tid >> 6, G = gridDim.x, bid = blockIdx.x;
    unsigned char* ws = P.ws;
    {
        LAS float* scr = (LAS float*)(lds + wave * 8448);
        const int gw = bid * NWAVES + wave, NGW = G * NWAVES;
        constexpr int I0 = (1024 / 64) * (DIN / 32), I1 = I0 + (1024 / 64) * (1024 / 32), I2 = I1 + (1280 / 64) * (1024 / 32), I3 = I2 + (1024 / 64) * (1024 / 32),
                      I4 = I3 + (1024 / 64) * (6144 / 32), I5 = I4 + (3072 / 64) * (1024 / 32);
        for (int it = gw; it < I5; it += NGW) {
            const float* W; int K, N, loc, pm; bf16_t* WT;
            if (it < I0) { W = P.in[11]; K = 1024; N = DIN; WT = (bf16_t*)(ws + WS_WIN); loc = it; pm = 1; }
            else if (it < I1) { W = P.in[16]; K = 1024; N = 1024; WT = (bf16_t*)(ws + WS_WCA); loc = it - I0; pm = 0; }
            else if (it < I2) { W = P.in[24]; K = 1280; N = 1024; WT = (bf16_t*)(ws + WS_WRB); loc = it - I1; pm = 0; }
            else if (it < I3) { W = P.in[25]; K = 1024; N = 1024; WT = (bf16_t*)(ws + WS_WO); loc = it - I2; pm = 0; }
            else if (it < I4) { W = P.in[27]; K = 1024; N = 6144; WT = (bf16_t*)(ws + WS_WUP); loc = it - I3; pm = 2; }
            else { W = P.in[30]; K = 3072; N = 1024; WT = (bf16_t*)(ws + WS_WDN); loc = it - I4; pm = 0; }
            const int nblk = N / 32, kb = loc / nblk, nb = loc % nblk, n0 = nb * 32;
            const int nd0 = pm == 1 ? perm_in(n0) : (pm == 2 ? perm_up(n0) : n0);
            transpose_item(W, K, N, WT, kb * 64, n0, nd0, scr, lane);
        }
    }
    {
        const int gt = bid * NTHREADS + tid, NT = G * NTHREADS;
        bf16_t* wrg = (bf16_t*)(ws + WS_WRG); bf16_t* wig = (bf16_t*)(ws + WS_WIG);
        for (int e = gt; e < 8 * 160 * 160; e += NT) { const int g = e / 25600, rem = e % 25600, j = rem / 160, i = rem % 160;
            const size_t src = (size_t)g * 25600 + (size_t)i * 160 + j;
            wrg[e] = (bf16_t)(pk_bf16(P.in[19][src], 0.f) & 0xffffu); wig[e] = (bf16_t)(pk_bf16(P.in[21][src], 0.f) & 0xffffu); }
        for (int e = gt; e < 1280; e += NT) ((float*)(ws + WS_SP8))[e] = 8.0f * log1pf(expf(-P.in[23][e]));
        for (int e = gt; e < 144 * 128; e += NT) { const int row = e >> 7, k8 = (e & 127) * 8;
            float av[8];
#pragma unroll
            for (int i = 0; i < 8; ++i) av[i] = 0.f;
            if (row < NBATCH) { const float* cp = (row < 8) ? P.in[6] + (size_t)row * 1024 : P.in[7] + (size_t)(row - 8) * 1024;
                const f32x4 c0 = *(const f32x4*)(cp + k8), c1 = *(const f32x4*)(cp + k8 + 4);
#pragma unroll
                for (int i = 0; i < 4; ++i) { av[i] = siluf_(c0[i]); av[4 + i] = siluf_(c1[i]); } }
            bf16x8 hi, lo; split8(av, hi, lo);
            *(bf16x8*)((bf16_t*)(ws + WS_SCH) + (size_t)row * 1024 + k8) = hi; *(bf16x8*)((bf16_t*)(ws + WS_SCL) + (size_t)row * 1024 + k8) = lo; }
        const f32x4* st = (const f32x4*)P.in[2]; f32x4* dst = (f32x4*)(P.out + O_CONF_S);
        for (int e = gt; e < 128 * 22 * 256; e += NT) { const int b = e / (22 * 256), rem = e % (22 * 256), i = rem / 256, c4 = rem % 256;
            dst[((size_t)b * 30 + i) * 256 + c4] = st[((size_t)b * 30 + i + 8) * 256 + c4]; }
    }
}
__device__ __forceinline__ void phase0_mod(const Params& P, LAS unsigned char* lds) {
    const int tid = opaque_tid(), lane = tid & 63, wave = tid >> 6, G = gridDim.x, bid = blockIdx.x;
    unsigned char* ws = P.ws;
    {
        const int fr = lane & 15, fq = lane >> 4;
        LAS float* red = (LAS float*)lds;
        const float* wada = P.in[8]; const float* bada = P.in[9];
        const bf16_t* sch = (const bf16_t*)(ws + WS_SCH); const bf16_t* scl = (const bf16_t*)(ws + WS_SCL);
        float* mod = (float*)(ws + WS_MOD);
        for (int task = bid; task < NMOD / 32; task += G) {
            const int n0 = task * 32, kbase = wave * 128;
            f32x4 acc[2][9];
#pragma unroll
            for (int t = 0; t < 2; ++t)
#pragma unroll
                for (int i = 0; i < 9; ++i) acc[t][i] = (f32x4){0.f, 0.f, 0.f, 0.f};
#pragma unroll 1
            for (int ks = 0; ks < 4; ++ks) {
                const int k0 = kbase + ks * 32 + fq * 8;
                float bv0[8], bv1[8];
#pragma unroll
                for (int i = 0; i < 8; ++i) { bv0[i] = wada[(size_t)(k0 + i) * NMOD + n0 + fr]; bv1[i] = wada[(size_t)(k0 + i) * NMOD + n0 + 16 + fr]; }
                bf16x8 ah[9], al[9];
#pragma unroll
                for (int rt = 0; rt < 9; ++rt) { ah[rt] = *(const bf16x8*)(sch + (size_t)(rt * 16 + fr) * 1024 + k0); al[rt] = *(const bf16x8*)(scl + (size_t)(rt * 16 + fr) * 1024 + k0); }
                bf16x8 bh0, bl0, bh1, bl1; split8(bv0, bh0, bl0); split8(bv1, bh1, bl1);
#pragma unroll
                for (int rt = 0; rt < 9; ++rt) {
                    acc[0][rt] = __builtin_amdgcn_mfma_f32_16x16x32_bf16(ah[rt], bh0, acc[0][rt], 0, 0, 0);
                    acc[0][rt] = __builtin_amdgcn_mfma_f32_16x16x32_bf16(al[rt], bh0, acc[0][rt], 0, 0, 0);
                    acc[0][rt] = __builtin_amdgcn_mfma_f32_16x16x32_bf16(ah[rt], bl0, acc[0][rt], 0, 0, 0);
                    acc[1][rt] = __builtin_amdgcn_mfma_f32_16x16x32_bf16(ah[rt], bh1, acc[1][rt], 0, 0, 0);
                    acc[1][rt] = __builtin_amdgcn_mfma_f32_16x16x32_bf16(al[rt], bh1, acc[1][rt], 0, 0, 0);
                    acc[1][rt] = __builtin_amdgcn_mfma_f32_16x16x32_bf16(ah[rt], bl1, acc[1][rt], 0, 0, 0);
                }
            }
#pragma unroll
            for (int t = 0; t < 2; ++t) {
#pragma unroll
                for (int rt = 0; rt < 9; ++rt)
#pragma unroll
                    for (int j = 0; j < 4; ++j) red[(wave * 144 + rt * 16 + fq * 4 + j) * 16 + fr] = acc[t][rt][j];
                __syncthreads();
                for (int idx = tid; idx < NBATCH * 16; idx += NTHREADS) { const int row = idx >> 4, col = idx & 15;
                    float s = bada[n0 + t * 16 + col];
#pragma unroll
                    for (int w = 0; w < 8; ++w) s += red[(w * 144 + row) * 16 + col];
                    mod[(size_t)row * NMOD + n0 + t * 16 + col] = s; }
                __syncthreads();
            }
        }
    }
}

template <int MODE>
__device__ __forceinline__ void phase_norm(const float* xp, const float* xs, const bf16_t* xb, const float* g, const float* mod, int shift_off, int scale_off, bf16_t* dst, float* ydst) {
    const int tid = opaque_tid(), lane = tid & 63, wave = tid >> 6;
    const int gw = blockIdx.x * NWAVES + wave, NGW = gridDim.x * NWAVES;
    for (int row0 = gw; row0 < MT; row0 += 2 * NGW) {
        f32x4 v[2][4], gv[4], sc[2][4], sh[2][4];
        int rows[2]; rows[0] = row0; rows[1] = (row0 + NGW < MT) ? row0 + NGW : row0;
#pragma unroll
        for (int j = 0; j < 4; ++j) gv[j] = *(const f32x4*)(g + 4 * lane + 256 * j);
#pragma unroll
        for (int t = 0; t < 2; ++t) {
            const int row = rows[t];
            if (MODE == 0) { const float* xr = (row < MP) ? xp + (size_t)row * 1024 : xs + (size_t)(row - MP) * 1024;
#pragma unroll
                for (int j = 0; j < 4; ++j) v[t][j] = *(const f32x4*)(xr + 4 * lane + 256 * j); }
            else {
#pragma unroll
                for (int j = 0; j < 4; ++j) { const u32x2 w = *(const u32x2*)(xb + (size_t)row * 1024 + 4 * lane + 256 * j); v[t][j] = (f32x4){bf_lo(w.x), bf_hi(w.x), bf_lo(w.y), bf_hi(w.y)}; } }
            if (MODE != 2) { const float* mp = mod + (size_t)batch_of_row(row) * NMOD;
#pragma unroll
                for (int j = 0; j < 4; ++j) { sc[t][j] = *(const f32x4*)(mp + scale_off + 4 * lane + 256 * j); sh[t][j] = *(const f32x4*)(mp + shift_off + 4 * lane + 256 * j); } }
        }
#pragma unroll
        for (int t = 0; t < 2; ++t) {
            const int row = rows[t];
            float ss = 0.f;
#pragma unroll
            for (int j = 0; j < 4; ++j) ss += v[t][j][0] * v[t][j][0] + v[t][j][1] * v[t][j][1] + v[t][j][2] * v[t][j][2] + v[t][j][3] * v[t][j][3];
            const float rstd = rsqrtf(wave_sum(ss) * (1.0f / 1024.0f) + EPS);
#pragma unroll
            for (int j = 0; j < 4; ++j) {
                const int c = 4 * lane + 256 * j;
                if (MODE == 2) { *(f32x4*)(ydst + (size_t)row * 1024 + c) = v[t][j] * rstd * gv[j]; }
                else {
                    f32x4 o;
#pragma unroll
                    for (int i = 0; i < 4; ++i) o[i] = v[t][j][i] * rstd * gv[j][i] * (1.0f + sc[t][j][i]) + sh[t][j][i];
                    u32x2 w; w.x = pk_bf16(o[0], o[1]); w.y = pk_bf16(o[2], o[3]);
                    *(u32x2*)(dst + (size_t)row * 1024 + c) = w;
                }
            }
        }
    }
}

constexpr int RB_RAW = 0, RB_XRB = 21504, RB_SA = 43008, RB_SB = 84992, RB_CAR = 126976;
__device__ __forceinline__ float neg_expm1(float x) {
    const float p = -x * (1.0f + x * (0.5f + x * (0.16666667f + x * (0.041666668f + x * (0.008333334f + x * 0.0013888889f)))));
    return (x > -0.25f) ? p : 1.0f - __expf(x);
}
struct RgPre { u32x4 v[3]; float cst; };
__device__ __forceinline__ void rglru_prefetch(const Params& P, int q, int tid, RgPre& pre) {
    const bf16_t* rnnx = (const bf16_t*)(P.ws + WS_S2);
    const bool sample = q >= 2048;
    int g, r0, c = 0;
    if (!sample) { g = q & 7; c = (q >> 3) & 31; r0 = (q >> 8) * 2048 + c * 64; }
    else { const int qs = q - 2048; g = qs & 7; r0 = MP + (qs >> 3) * 64; }
#pragma unroll
    for (int u = 0; u < 3; ++u) { const int idx = u * NTHREADS + tid, i = idx / 20, ck = idx % 20;
        pre.v[u] = (u32x4){0u, 0u, 0u, 0u};
        const bool valid = (idx < 67 * 20) && (sample ? (i >= 3) : (c > 0 || i >= 3));
        if (valid) pre.v[u] = *(const u32x4*)(rnnx + (size_t)(r0 - 3 + i) * 1280 + g * 160 + ck * 8); }
    pre.cst = 0.f;
    if (tid < 480) { const int k = tid / 160, cc = tid % 160; const float* sp = (k == 0) ? P.in[20] : (k == 1 ? P.in[22] : (const float*)(P.ws + WS_SP8)); pre.cst = sp[g * 160 + cc]; }
}
__device__ __forceinline__ void rglru_task(const Params& P, LAS unsigned char* lds, int q, RgPre& pre, int qn) {
    const int tid = opaque_tid(), lane = tid & 63, wave = tid >> 6, fr = lane & 15, fq = lane >> 4;
    unsigned char* ws = P.ws;
    const bf16_t* rnnx = (const bf16_t*)(ws + WS_S2);
    bf16_t* gghg = (bf16_t*)(ws + WS_S3); bf16_t* pg = (bf16_t*)(ws + WS_S4);
    const bool sample = q >= 2048;
    int g, r0, b = 0, c = 0, sb0 = 0;
    if (!sample) { g = q & 7; c = (q >> 3) & 31; b = q >> 8; r0 = b * 2048 + c * 64; }
    else { const int qs = q - 2048; g = qs & 7; sb0 = (qs >> 3) * 8; r0 = MP + (qs >> 3) * 64; }
    LAS bf16_t* RAW = (LAS bf16_t*)(lds + RB_RAW);
    LAS bf16_t* XRB = (LAS bf16_t*)(lds + RB_XRB);
    LAS float* SA = (LAS float*)(lds + RB_SA);
    LAS float* SB = (LAS float*)(lds + RB_SB);
    LAS float* CAR = (LAS float*)(lds + RB_CAR);
    LAS float* CST = (LAS float*)(lds + LDS_STAGE);
    const bf16_t* wrg = (const bf16_t*)(ws + WS_WRG) + (size_t)g * 25600; const bf16_t* wig = (const bf16_t*)(ws + WS_WIG) + (size_t)g * 25600;
    int ctc = (wave * 5) >> 2;
    bf16x8 fwr[5], fwi[5];
#pragma unroll
    for (int ks = 0; ks < 5; ++ks) { fwr[ks] = *(const bf16x8*)(wrg + (size_t)(ctc * 16 + fr) * 160 + ks * 32 + fq * 8); fwi[ks] = *(const bf16x8*)(wig + (size_t)(ctc * 16 + fr) * 160 + ks * 32 + fq * 8); }
    if (tid < 480) CST[tid] = pre.cst;
#pragma unroll
    for (int u = 0; u < 3; ++u) { const int idx = u * NTHREADS + tid, i = idx / 20, ck = idx % 20;
        if (idx < 67 * 20) *(LAS u32x4*)(RAW + i * 160 + ck * 8) = pre.v[u]; }
    __syncthreads();
    if (tid < 480) {
        const int cp = tid % 80, rg = tid / 80, ch = cp * 2, chg = g * 160 + ch;
        const f32x2 bs = *(const f32x2*)(P.in[18] + chg);
        f32x2 w[4];
#pragma unroll
        for (int j = 0; j < 4; ++j) w[j] = *(const f32x2*)(P.in[17] + (size_t)j * 1280 + chg);
        const int lr0 = rg * 11, lr1 = (lr0 + 11 < 64) ? lr0 + 11 : 64;
        if (!sample) {
            unsigned x0 = *(const LAS unsigned*)(RAW + (lr0 + 0) * 160 + ch), x1 = *(const LAS unsigned*)(RAW + (lr0 + 1) * 160 + ch), x2 = *(const LAS unsigned*)(RAW + (lr0 + 2) * 160 + ch);
            for (int lr = lr0; lr < lr1; ++lr) {
                const unsigned x3 = *(const LAS unsigned*)(RAW + (lr + 3) * 160 + ch);
                const float a0 = bs[0] + w[0][0] * bf_lo(x0) + w[1][0] * bf_lo(x1) + w[2][0] * bf_lo(x2) + w[3][0] * bf_lo(x3);
                const float a1 = bs[1] + w[0][1] * bf_hi(x0) + w[1][1] * bf_hi(x1) + w[2][1] * bf_hi(x2) + w[3][1] * bf_hi(x3);
                *(LAS unsigned*)(XRB + lr * 168 + ch) = pk_bf16(a0, a1);
                x0 = x1; x1 = x2; x2 = x3;
            }
        } else {
            for (int lr = lr0; lr < lr1; ++lr) {
                const int t = lr & 7;
                f32x2 a = bs;
#pragma unroll
                for (int j = 0; j < 4; ++j) {
                    float x0, x1;
                    if (t + j < 3) { const f32x2 sv = *(const f32x2*)(P.in[3] + ((size_t)(sb0 + (lr >> 3)) * 3 + t + j) * 1280 + chg); x0 = sv[0]; x1 = sv[1]; }
                    else { const unsigned rw = *(const LAS unsigned*)(RAW + (lr + j) * 160 + ch); x0 = bf_lo(rw); x1 = bf_hi(rw); }
                    a[0] += w[j][0] * x0; a[1] += w[j][1] * x1;
                }
                *(LAS unsigned*)(XRB + lr * 168 + ch) = pk_bf16(a[0], a[1]);
            }
        }
    }
    __syncthreads();
    if (qn >= 0) rglru_prefetch(P, qn, tid, pre);
    u32x4 gpre[3];
#pragma unroll
    for (int u = 0; u < 3; ++u) { const int idx = u * NTHREADS + tid; gpre[u] = (u32x4){0u, 0u, 0u, 0u};
        if (idx < 64 * 20) gpre[u] = *(const u32x4*)(gghg + (size_t)(r0 + idx / 20) * 1280 + g * 160 + (idx % 20) * 8); }
    {
#pragma unroll
        for (int i = 0; i < 5; ++i) {
            const int idx = wave * 5 + i, ct = idx >> 2, rt = idx & 3;
            if (ct != ctc) { ctc = ct;
#pragma unroll
                for (int ks = 0; ks < 5; ++ks) { fwr[ks] = *(const bf16x8*)(wrg + (size_t)(ct * 16 + fr) * 160 + ks * 32 + fq * 8); fwi[ks] = *(const bf16x8*)(wig + (size_t)(ct * 16 + fr) * 160 + ks * 32 + fq * 8); } }
            f32x4 ar = {0.f, 0.f, 0.f, 0.f}, ai = {0.f, 0.f, 0.f, 0.f};
#pragma unroll
            for (int ks = 0; ks < 5; ++ks) {
                const bf16x8 xb = *(const LAS bf16x8*)(XRB + (rt * 16 + fr) * 168 + ks * 32 + fq * 8);
                ar = __builtin_amdgcn_mfma_f32_16x16x32_bf16(fwr[ks], xb, ar, 0, 0, 0);
                ai = __builtin_amdgcn_mfma_f32_16x16x32_bf16(fwi[ks], xb, ai, 0, 0, 0);
            }
            const int chl = ct * 16 + fq * 4, chg = g * 160 + chl, lr = rt * 16 + fr;
            const f32x4 brg = *(const LAS f32x4*)(CST + chl), big = *(const LAS f32x4*)(CST + 160 + chl), sp8 = *(const LAS f32x4*)(CST + 320 + chl);
            const u32x2 xw = *(const LAS u32x2*)(XRB + lr * 168 + chl);
            const float xr[4] = {bf_lo(xw.x), bf_hi(xw.x), bf_lo(xw.y), bf_hi(xw.y)};
            f32x4 av, bx;
#pragma unroll
            for (int jp = 0; jp < 2; ++jp) {
                const f32x2 zr = {ar[2 * jp] + brg[2 * jp], ar[2 * jp + 1] + brg[2 * jp + 1]}, zi = {ai[2 * jp] + big[2 * jp], ai[2 * jp + 1] + big[2 * jp + 1]};
                const f32x2 r = sigmoid2(zr), ig = sigmoid2(zi);
                const f32x2 sp = {sp8[2 * jp], sp8[2 * jp + 1]}, xv = {xr[2 * jp], xr[2 * jp + 1]};
                const f32x2 la = -(r * sp);
                const f32x2 tl = la * 1.4426950408889634f;
                av[2 * jp] = __builtin_amdgcn_exp2f(tl.x); av[2 * jp + 1] = __builtin_amdgcn_exp2f(tl.y);
                const f32x2 x2 = la + la;
                f32x2 m2 = -x2 * (1.0f + x2 * (0.5f + x2 * (0.16666667f + x2 * (0.041666668f + x2 * (0.008333334f + x2 * 0.0013888889f)))));
                if (__builtin_amdgcn_ballot_w64(x2.x <= -0.25f || x2.y <= -0.25f) != 0ull) {
                    m2.x = (x2.x > -0.25f) ? m2.x : 1.0f - __expf(x2.x); m2.y = (x2.y > -0.25f) ? m2.y : 1.0f - __expf(x2.y); }
                f32x2 sq; sq.x = __builtin_sqrtf(m2.x); sq.y = __builtin_sqrtf(m2.y);
                const f32x2 bxv = sq * ig * xv;
                bx[2 * jp] = bxv.x; bx[2 * jp + 1] = bxv.y;
            }
            *(LAS f32x4*)(SA + lr * 164 + chl) = av; *(LAS f32x4*)(SB + lr * 164 + chl) = bx;
        }
    }
    __syncthreads();
    if (tid < 480) {
        const int ch = tid % 160, sg = tid / 160, chg = g * 160 + ch;
        if (!sample) {
            const int lr0 = sg == 0 ? 0 : (sg == 1 ? 22 : 43), lr1 = sg == 0 ? 22 : (sg == 1 ? 43 : 64);
            float h = 0.f, pr = 1.f;
            float av[22], bv[22];
#pragma unroll
            for (int i = 0; i < 22; ++i) { const int lr = (lr0 + i < lr1) ? lr0 + i : lr1 - 1; av[i] = SA[lr * 164 + ch]; bv[i] = SB[lr * 164 + ch]; }
#pragma unroll
            for (int i = 0; i < 22; ++i) { if (lr0 + i < lr1) { h = av[i] * h + bv[i]; pr *= av[i]; } bv[i] = h; av[i] = pr; }
#pragma unroll
            for (int i = 0; i < 22; ++i) { if (lr0 + i < lr1) { SB[(lr0 + i) * 164 + ch] = bv[i]; SA[(lr0 + i) * 164 + ch] = av[i]; } }
            CAR[sg * 160 + ch] = h; CAR[480 + sg * 160 + ch] = pr;
        } else {
            const int s0 = sg * 3, s1 = (s0 + 3 < 8) ? s0 + 3 : 8;
            for (int s = s0; s < s1; ++s) {
                float h = P.in[4][(size_t)(sb0 + s) * 1280 + chg];
#pragma unroll
                for (int t = 0; t < 8; ++t) { const int lr = s * 8 + t; h = SA[lr * 164 + ch] * h + SB[lr * 164 + ch]; SB[lr * 164 + ch] = h; }
                P.out[O_H_S + (size_t)(sb0 + s) * 1280 + chg] = h;
            }
        }
    }
    __syncthreads();
    if (!sample && tid < 160) {
        const float h0 = CAR[tid], h1 = CAR[160 + tid], h2 = CAR[320 + tid], p0 = CAR[480 + tid], p1 = CAR[640 + tid], p2 = CAR[800 + tid];
        const float c1 = h0, c2 = h1 + p1 * c1;
        ((float*)(ws + WS_HL))[((size_t)b * 32 + c) * 1280 + g * 160 + tid] = h2 + p2 * c2;
        ((float*)(ws + WS_PL))[((size_t)b * 32 + c) * 1280 + g * 160 + tid] = p0 * p1 * p2;
    }
#pragma unroll
    for (int u = 0; u < 3; ++u) { const int idx = u * NTHREADS + tid; if (idx >= 64 * 20) break; const int lr = idx / 20, ch = (idx % 20) * 8;
        const size_t off = (size_t)(r0 + lr) * 1280 + g * 160 + ch;
        const u32x4 gw = gpre[u];
        const float gv[8] = {bf_lo(gw.x), bf_hi(gw.x), bf_lo(gw.y), bf_hi(gw.y), bf_lo(gw.z), bf_hi(gw.z), bf_lo(gw.w), bf_hi(gw.w)};
        f32x4 h0 = *(const LAS f32x4*)(SB + lr * 164 + ch), h1 = *(const LAS f32x4*)(SB + lr * 164 + ch + 4);
        if (!sample) {
            f32x4 p0 = *(const LAS f32x4*)(SA + lr * 164 + ch), p1 = *(const LAS f32x4*)(SA + lr * 164 + ch + 4);
            if (lr >= 22) {
                const int sg = lr >= 43 ? 2 : 1;
#pragma unroll
                for (int k = 0; k < 2; ++k) {
                    const f32x4 e0 = *(const LAS f32x4*)(CAR + ch + 4 * k), q0 = *(const LAS f32x4*)(CAR + 480 + ch + 4 * k);
                    f32x4 cin = e0, qin = q0;
                    if (sg == 2) { const f32x4 e1 = *(const LAS f32x4*)(CAR + 160 + ch + 4 * k), q1 = *(const LAS f32x4*)(CAR + 640 + ch + 4 * k); cin = e1 + q1 * e0; qin = q0 * q1; }
                    if (k == 0) { h0 = h0 + p0 * cin; p0 = p0 * qin; } else { h1 = h1 + p1 * cin; p1 = p1 * qin; }
                }
            }
            u32x4 o2; o2.x = pk_bf16(p0[0] * gv[0], p0[1] * gv[1]); o2.y = pk_bf16(p0[2] * gv[2], p0[3] * gv[3]); o2.z = pk_bf16(p1[0] * gv[4], p1[1] * gv[5]); o2.w = pk_bf16(p1[2] * gv[6], p1[3] * gv[7]);
            *(u32x4*)(pg + off) = o2;
        }
        u32x4 o; o.x = pk_bf16(h0[0] * gv[0], h0[1] * gv[1]); o.y = pk_bf16(h0[2] * gv[2], h0[3] * gv[3]); o.z = pk_bf16(h1[0] * gv[4], h1[1] * gv[5]); o.w = pk_bf16(h1[2] * gv[6], h1[3] * gv[7]);
        *(u32x4*)(gghg + off) = o; }
    __syncthreads();
}

template <int R>
__device__ __forceinline__ void conf_task(const Params& P, LAS unsigned char* lds, int r0, int t0, int sb, bool sample, const f32x2 (&w)[31], f32x2 bias) {
    const int tid = opaque_tid(), lane = tid & 63, wave = tid >> 6;
    const bf16_t* uglu = (const bf16_t*)(P.ws + WS_S1);
    bf16_t* ua = (bf16_t*)(P.ws + WS_S0);
    LAS bf16_t* ST = (LAS bf16_t*)lds;
    {
        constexpr int NCH = (R + 30) * 128, PER = (NCH + NTHREADS - 1) / NTHREADS, NB = PER / 2;
#pragma unroll
        for (int h = 0; h < 2; ++h) {
            u32x4 v[NB]; f32x4 fa[NB], fb[NB];
#pragma unroll
            for (int u = 0; u < NB; ++u) {
                const int idx = (h * NB + u) * NTHREADS + tid, i = idx >> 7, ck = idx & 127;
                v[u] = (u32x4){0u, 0u, 0u, 0u}; fa[u] = (f32x4){0.f, 0.f, 0.f, 0.f}; fb[u] = fa[u];
                if (idx < NCH) {
                    if (!sample) { if (t0 - 30 + i >= 0) v[u] = *(const u32x4*)(uglu + (size_t)(r0 - 30 + i) * 1024 + ck * 8); }
                    else if (i < 30) { const float* sp = P.in[2] + ((size_t)sb * 30 + i) * 1024 + ck * 8; fa[u] = *(const f32x4*)sp; fb[u] = *(const f32x4*)(sp + 4); }
                    else v[u] = *(const u32x4*)(uglu + (size_t)(r0 + i - 30) * 1024 + ck * 8);
                }
            }
#pragma unroll
            for (int u = 0; u < NB; ++u) {
                const int idx = (h * NB + u) * NTHREADS + tid, i = idx >> 7, ck = idx & 127;
                if (idx < NCH) {
                    u32x4 o = v[u];
                    if (sample && i < 30) { o.x = pk_bf16(fa[u][0], fa[u][1]); o.y = pk_bf16(fa[u][2], fa[u][3]); o.z = pk_bf16(fb[u][0], fb[u][1]); o.w = pk_bf16(fb[u][2], fb[u][3]); }
                    *(LAS u32x4*)(ST + i * 1024 + ck * 8) = o;
                }
            }
        }
    }
    __syncthreads();
    f32x2 acc[R];
#pragma unroll
    for (int r = 0; r < R; ++r) acc[r] = bias;
#pragma unroll
    for (int i = 0; i < R + 30; ++i) {
        const unsigned rw = *(const LAS unsigned*)(ST + i * 1024 + 2 * tid);
        const f32x2 v = {bf_lo(rw), bf_hi(rw)};
#pragma unroll
        for (int r = 0; r < R; ++r) { const int tap = i - r; if (tap >= 0 && tap <= 30) acc[r] += v * w[tap]; }
    }
    __syncthreads();
    LAS float* CO = (LAS float*)lds;
#pragma unroll
    for (int r = 0; r < R; ++r) *(LAS f32x2*)(CO + r * 1024 + 2 * tid) = acc[r];
    __syncthreads();
    for (int r = wave; r < R; r += NWAVES) {
        f32x4 v[4]; float s = 0.f;
#pragma unroll
        for (int k = 0; k < 4; ++k) { v[k] = *(const LAS f32x4*)(CO + r * 1024 + 4 * lane + 256 * k); s += (v[k][0] + v[k][1]) + (v[k][2] + v[k][3]); }
        const float mean = wave_sum(s) * (1.0f / 1024.0f); float s2 = 0.f;
#pragma unroll
        for (int k = 0; k < 4; ++k) { v[k] = v[k] - mean; s2 += (v[k][0] * v[k][0] + v[k][1] * v[k][1]) + (v[k][2] * v[k][2] + v[k][3] * v[k][3]); }
        const float rstd = rsqrtf(wave_sum(s2) * (1.0f / 1024.0f) + EPS);
#pragma unroll
        for (int k = 0; k < 4; ++k) { const int c = 4 * lane + 256 * k;
            const f32x4 gv = *(const f32x4*)(P.in[14] + c), bv = *(const f32x4*)(P.in[15] + c);
            float o[4];
#pragma unroll
            for (int i = 0; i < 4; ++i) o[i] = siluf_(v[k][i] * rstd * gv[i] + bv[i]);
            u32x2 wv; wv.x = pk_bf16(o[0], o[1]); wv.y = pk_bf16(o[2], o[3]);
            *(u32x2*)(ua + (size_t)(r0 + r) * 1024 + c) = wv; }
    }
    __syncthreads();
}

__device__ __forceinline__ void fix_task(const Params& P, LAS unsigned char* lds, int q) {
    const int tid = opaque_tid();
    const int b = q / 31, c = 1 + q % 31;
    LAS float* Hs = (LAS float*)lds;
    const float* hl = (const float*)(P.ws + WS_HL) + (size_t)b * 32 * 1280; const float* pl = (const float*)(P.ws + WS_PL) + (size_t)b * 32 * 1280;
    for (int ch = tid; ch < 1280; ch += NTHREADS) {
        float hv[32], pv[32];
#pragma unroll
        for (int cc = 0; cc < 32; ++cc) { const int ce = cc <= c ? cc : c; hv[cc] = hl[(size_t)ce * 1280 + ch]; pv[cc] = pl[(size_t)ce * 1280 + ch]; }
        float H = 0.f;
#pragma unroll
        for (int cc = 0; cc < 31; ++cc) H = (cc < c) ? hv[cc] + pv[cc] * H : H;
        Hs[ch] = H;
        if (c == 31) P.out[O_H_P + (size_t)b * 1280 + ch] = hv[31] + pv[31] * H;
    }
    __syncthreads();
    bf16_t* hg = (bf16_t*)(P.ws + WS_S3); const bf16_t* pg = (const bf16_t*)(P.ws + WS_S4);
    const int r0 = b * 2048 + c * 64;
    for (int base = 0; base < 64 * 160; base += 4 * NTHREADS) {
        u32x4 hw[4], pw[4];
#pragma unroll
        for (int u = 0; u < 4; ++u) { const int idx = base + u * NTHREADS + tid, lr = idx / 160, ch = (idx % 160) * 8; const size_t off = (size_t)(r0 + lr) * 1280 + ch;
            hw[u] = *(const u32x4*)(hg + off); pw[u] = *(const u32x4*)(pg + off); }
#pragma unroll
        for (int u = 0; u < 4; ++u) { const int idx = base + u * NTHREADS + tid, lr = idx / 160, ch = (idx % 160) * 8; const size_t off = (size_t)(r0 + lr) * 1280 + ch;
            const f32x4 H0 = *(const LAS f32x4*)(Hs + ch), H1 = *(const LAS f32x4*)(Hs + ch + 4);
            u32x4 o;
            o.x = pk_bf16(bf_lo(hw[u].x) + bf_lo(pw[u].x) * H0[0], bf_hi(hw[u].x) + bf_hi(pw[u].x) * H0[1]);
            o.y = pk_bf16(bf_lo(hw[u].y) + bf_lo(pw[u].y) * H0[2], bf_hi(hw[u].y) + bf_hi(pw[u].y) * H0[3]);
            o.z = pk_bf16(bf_lo(hw[u].z) + bf_lo(pw[u].z) * H1[0], bf_hi(hw[u].z) + bf_hi(pw[u].z) * H1[1]);
            o.w = pk_bf16(bf_lo(hw[u].w) + bf_lo(pw[u].w) * H1[2], bf_hi(hw[u].w) + bf_hi(pw[u].w) * H1[3]);
            *(u32x4*)(hg + off) = o; }
    }
    __syncthreads();
}

template <int K>
__device__ __forceinline__ void small_gemm(LAS unsigned char* lds, const bf16_t* A, const bf16_t* Bt, int m0, int n0, int tid, f32x4 (&acc)[2]) {
    static_assert(K % 128 == 0, "K multiple of 128");
    constexpr int RS = 272, ABYTES = 128 * RS, BUF = 160 * RS;
    const int lane = tid & 63, wave = tid >> 6, fr = lane & 15, fq = lane >> 4;
    const int srow = tid >> 4, sc = tid & 15;
    const bf16_t* ga = A + (size_t)(m0 + srow) * K + sc * 8;
    const bf16_t* gb = Bt + (size_t)(n0 + srow) * K + sc * 8;
    static_assert((K / 128) % 2 == 0, "even number of K-chunks");
    u32x4 r0[4], r0b, r1[4], r1b;
#define SG_LOAD(R, RB, c) do { _Pragma("unroll") for (int u = 0; u < 4; ++u) R[u] = *(const u32x4*)(ga + (size_t)(32 * u) * K + (c) * 128); RB = *(const u32x4*)(gb + (c) * 128); } while (0)
#define SG_STORE(R, RB, buf) do { _Pragma("unroll") for (int u = 0; u < 4; ++u) *(LAS u32x4*)((buf) + (srow + 32 * u) * RS + sc * 16) = R[u]; *(LAS u32x4*)((buf) + ABYTES + srow * RS + sc * 16) = RB; } while (0)
#define SG_COMPUTE(buf) do { _Pragma("unroll") for (int ks = 0; ks < 4; ++ks) { \
        const bf16x8 a = *(const LAS bf16x8*)((buf) + aoff + ks * 64), b0 = *(const LAS bf16x8*)((buf) + boff + ks * 64), b1 = *(const LAS bf16x8*)((buf) + boff + 16 * RS + ks * 64); \
        acc[0] = __builtin_amdgcn_mfma_f32_16x16x32_bf16(b0, a, acc[0], 0, 0, 0); acc[1] = __builtin_amdgcn_mfma_f32_16x16x32_bf16(b1, a, acc[1], 0, 0, 0); } } while (0)
    const int aoff = (wave * 16 + fr) * RS + fq * 16, boff = ABYTES + fr * RS + fq * 16;
    LAS unsigned char* buf0 = lds; LAS unsigned char* buf1 = lds + BUF;
    SG_LOAD(r0, r0b, 0); SG_LOAD(r1, r1b, 1);
    SG_STORE(r0, r0b, buf0);
    __syncthreads();
#pragma unroll 1
    for (int kc = 0; kc < K / 128; kc += 2) {
        if (kc + 2 < K / 128) SG_LOAD(r0, r0b, kc + 2);
        SG_COMPUTE(buf0);
        SG_STORE(r1, r1b, buf1);
        __syncthreads();
        if (kc + 3 < K / 128) SG_LOAD(r1, r1b, kc + 3);
        SG_COMPUTE(buf1);
        if (kc + 2 < K / 128) SG_STORE(r0, r0b, buf0);
        __syncthreads();
    }
#undef SG_LOAD
#undef SG_STORE
#undef SG_COMPUTE
}

#define XB_TMO      128
#define XB_XCNT(j)  (256  + 64 * (j))
#define XB_XSUB(j)  (1280 + 64 * (j))
#define XB_XGEN(j)  (2304 + 64 * (j))
#define XB_TOP      3328
#define XB_TOPGEN   3392
#define XCD_BAR_WORDS 3456
#define XB_SPIN_CAP (1u << 18)
__device__ __forceinline__ unsigned xb_ld(unsigned* p)              { return __hip_atomic_load(p, __ATOMIC_RELAXED, __HIP_MEMORY_SCOPE_AGENT); }
__device__ __forceinline__ unsigned xb_add(unsigned* p, unsigned v) { return __hip_atomic_fetch_add(p, v, __ATOMIC_RELAXED, __HIP_MEMORY_SCOPE_AGENT); }
__device__ __forceinline__ unsigned xb_xcc_id() { return (unsigned)__builtin_amdgcn_s_getreg((3 << 11) | 20) & 0xFu; }
#define XB_SPIN(cond, bar) do { unsigned _sp = 0; while (cond) { __builtin_amdgcn_s_sleep(1); \
    if ((++_sp & 255u) == 0u) { if (xb_ld(&(bar)[XB_TMO])) break; if (_sp > XB_SPIN_CAP) { atomicAdd(&(bar)[XB_TMO], 1u); break; } } } } while (0)
struct XcdBarrier { unsigned* bar; unsigned x; volatile LAS unsigned* st; };
__device__ __forceinline__ XcdBarrier xcd_barrier_post(unsigned* bar, volatile LAS unsigned* st) {
    XcdBarrier b; b.bar = bar; b.x = xb_xcc_id(); b.st = st;
    if (threadIdx.x == 0) (void)xb_add(&bar[XB_XCNT(b.x)], 1u);
    return b;
}
__device__ __forceinline__ void xcd_barrier_complete(unsigned* bar, unsigned x, unsigned& nloc, unsigned& nx) {
    const unsigned G = gridDim.x * gridDim.y * gridDim.z;
    unsigned sum, cnt, mine, sp = 0u;
    for (;;) {
        sum = 0u; cnt = 0u; mine = 0u;
#pragma unroll
        for (unsigned j = 0; j < 16; ++j) { const unsigned c = xb_ld(&bar[XB_XCNT(j)]); sum += c; cnt += (c > 0u) ? 1u : 0u; mine = (j == x) ? c : mine; }
        if (sum == G) break;
        __builtin_amdgcn_s_sleep(1);
        if ((++sp & 255u) == 0u) { if (xb_ld(&bar[XB_TMO])) break; if (sp > XB_SPIN_CAP) { atomicAdd(&bar[XB_TMO], 1u); break; } }
    }
    nloc = mine > 0u ? mine : 1u; nx = cnt > 0u ? cnt : 1u;
}
__device__ __forceinline__ void xcd_barrier(const XcdBarrier& b) {
    asm volatile("s_waitcnt vmcnt(0)" ::: "memory");
    __syncthreads();
    if (threadIdx.x == 0) {
        unsigned* bar = b.bar;
        __builtin_amdgcn_s_waitcnt(0);
        unsigned nloc = b.st[0], nx = b.st[1];
        if (nloc == 0u) { xcd_barrier_complete(bar, b.x, nloc, nx); b.st[0] = nloc; b.st[1] = nx; }
        const unsigned old = xb_add(&bar[XB_XSUB(b.x)], 1u);
        const unsigned gen = old / nloc;
        if (old + 1u == (gen + 1u) * nloc) {
            __builtin_amdgcn_fence(__ATOMIC_RELEASE, "agent");
            asm volatile("s_waitcnt vmcnt(0)" ::: "memory");
            const unsigned og = xb_add(&bar[XB_TOP], 1u);
            const unsigned tg = og / nx;
            if (og + 1u == (tg + 1u) * nx) xb_add(&bar[XB_TOPGEN], 1u);
            else XB_SPIN(xb_ld(&bar[XB_TOPGEN]) == tg, bar);
            __builtin_amdgcn_fence(__ATOMIC_ACQUIRE, "agent");
            xb_add(&bar[XB_XGEN(b.x)], 1u);
            asm volatile("s_waitcnt vmcnt(0)" ::: "memory");
        } else {
            XB_SPIN(xb_ld(&bar[XB_XGEN(b.x)]) == gen, bar);
            __builtin_amdgcn_fence(__ATOMIC_ACQUIRE, "agent");
            asm volatile("s_waitcnt vmcnt(0)" ::: "memory");
        }
    }
    __syncthreads();
}

__global__ void __launch_bounds__(NTHREADS, 2) fwd_megakernel(Params P) {
    extern __shared__ __attribute__((aligned(16))) unsigned char lds_raw[];
    LAS unsigned char* lds = (LAS unsigned char*)lds_raw;
    cg::grid_group grid = cg::this_grid();
    const int tid = threadIdx.x, G = gridDim.x, bid = blockIdx.x;
    unsigned char* ws = P.ws;
    float* mod = (float*)(ws + WS_MOD);
    bf16_t* xmid = (bf16_t*)(ws + WS_S3);
    if (tid < 4) ((LAS unsigned*)(lds + LDS_BARW))[tid] = 0u;
    __syncthreads();
    const XcdBarrier xbar = xcd_barrier_post((unsigned*)(ws + WS_BAR), (volatile LAS unsigned*)(lds + LDS_BARW));
    if (P.ws == nullptr) grid.sync();

    for (int rep = 0; rep < REPS(0); ++rep) { phase0(P, lds); xcd_barrier(xbar); phase0_mod(P, lds); xcd_barrier(xbar); }
    phase_norm<0>(P.in[0], P.in[1], nullptr, P.in[10], mod, 0, 1024, (bf16_t*)(ws + WS_S0), nullptr);
    xcd_barrier(xbar);
    for (int rep = 0; rep < REPS(2); ++rep) {
        if (rep) xcd_barrier(xbar);
        pg8::Gemm g{(const bf16_t*)(ws + WS_S0), (const bf16_t*)(ws + WS_WIN), MT, DIN, 1024}; pg8::StaticOrder S; S.init(MT, DIN, G, bid);
        EpiIn E{(bf16_t*)(ws + WS_S1), (bf16_t*)(ws + WS_S2), (bf16_t*)(ws + WS_S3), (bf16_t*)(P.out + O_Y), (bf16_t*)(P.out + O_Y) + (size_t)MT * 1024, P.out};
        pg8::gemm_phase<EpiIn>(lds, g, S, E);
    }
    xcd_barrier(xbar);
    {
        const int vb = (G % 8 == 0) ? (bid % 8) * (G / 8) + bid / 8 : bid;
        { RgPre pre; if (vb < 2176) rglru_prefetch(P, vb, opaque_tid(), pre);
          for (int q = vb; q < 2176; q += G) rglru_task(P, lds, q, pre, (q + G < 2176) ? q + G : -1); }
        f32x2 w[31];
#pragma unroll
        for (int j = 0; j < 31; ++j) w[j] = *(const f32x2*)(P.in[12] + (size_t)j * 1024 + 2 * tid);
        const f32x2 bias = *(const f32x2*)(P.in[13] + 2 * tid);
        for (int rep = 0; rep < REPS(3); ++rep)
        for (int q = (vb + G / 2) % G; q < 1152; q += G) {
            if (q < 1024) { const int b = q >> 7, t0 = (q & 127) * 16; conf_task<16>(P, lds, b * 2048 + t0, t0, 0, false, w, bias); }
            else { const int sb = q - 1024; conf_task<8>(P, lds, MP + sb * 8, 0, sb, true, w, bias); }
        }
    }
    xcd_barrier(xbar);
    for (int q = bid; q < 248; q += G) fix_task(P, lds, q);
    xcd_barrier(xbar);
    for (int rep = 0; rep < REPS(5); ++rep) {
        if (rep) xcd_barrier(xbar);
        pg8::StaticOrder S; S.init(MP, 1024, G, bid);
        { pg8::Gemm g{(const bf16_t*)(ws + WS_S0), (const bf16_t*)(ws + WS_WCA), MP, 1024, 1024};
          EpiMerge<0> E{(bf16_t*)(ws + WS_S1), (const bf16_t*)(P.out + O_Y)}; pg8::gemm_phase<EpiMerge<0>>(lds, g, S, E); }
        { pg8::Gemm g{(const bf16_t*)(ws + WS_S3), (const bf16_t*)(ws + WS_WRB), MP, 1024, 1280};
          EpiMerge<1> E{(bf16_t*)(ws + WS_S1), (const bf16_t*)(P.out + O_Y) + (size_t)MT * 1024}; pg8::gemm_phase<EpiMerge<1>>(lds, g, S, E); }
        {
            const int t2 = opaque_tid(), lane = t2 & 63, wave = t2 >> 6, fr = lane & 15, fq = lane >> 4;
            const bf16_t* sga = (const bf16_t*)(P.out + O_Y); const bf16_t* sgb = sga + (size_t)MT * 1024; bf16_t* mg = (bf16_t*)(ws + WS_S1);
            for (int t = bid; t < 256; t += G) {
                const int m0 = MP + (t >> 5) * 128, n0 = (t & 31) * 32;
                f32x4 a1[2] = {{0.f, 0.f, 0.f, 0.f}, {0.f, 0.f, 0.f, 0.f}}, a2[2] = {{0.f, 0.f, 0.f, 0.f}, {0.f, 0.f, 0.f, 0.f}};
                small_gemm<1024>(lds, (const bf16_t*)(ws + WS_S0), (const bf16_t*)(ws + WS_WCA), m0, n0, t2, a1);
                small_gemm<1280>(lds, (const bf16_t*)(ws + WS_S3), (const bf16_t*)(ws + WS_WRB), m0, n0, t2, a2);
#pragma unroll
                for (int ct = 0; ct < 2; ++ct) { const size_t off = (size_t)(m0 + wave * 16 + fr) * 1024 + n0 + ct * 16 + 4 * fq;
                    const u32x2 ga = *(const u32x2*)(sga + off), gb = *(const u32x2*)(sgb + off);
                    u32x2 o; o.x = pk_bf16(a1[ct][0] * bf_lo(ga.x) + a2[ct][0] * bf_lo(gb.x), a1[ct][1] * bf_hi(ga.x) + a2[ct][1] * bf_hi(gb.x));
                    o.y = pk_bf16(a1[ct][2] * bf_lo(ga.y) + a2[ct][2] * bf_lo(gb.y), a1[ct][3] * bf_hi(ga.y) + a2[ct][3] * bf_hi(gb.y));
                    *(u32x2*)(mg + off) = o; }
            }
        }
    }
    xcd_barrier(xbar);
    for (int rep = 0; rep < REPS(6); ++rep) {
        if (rep) xcd_barrier(xbar);
        pg8::Gemm g{(const bf16_t*)(ws + WS_S1), (const bf16_t*)(ws + WS_WO), MP, 1024, 1024}; pg8::StaticOrder S; S.init(MP, 1024, G, bid);
        EpiRes<false> E{P.in[0], xmid, mod, 2048}; pg8::gemm_phase<EpiRes<false>>(lds, g, S, E);
        {
            const int t2 = opaque_tid(), lane = t2 & 63, wave = t2 >> 6, fr = lane & 15, fq = lane >> 4;
            for (int t = bid; t < 256; t += G) {
                const int m0 = MP + (t >> 5) * 128, n0 = (t & 31) * 32;
                f32x4 a1[2] = {{0.f, 0.f, 0.f, 0.f}, {0.f, 0.f, 0.f, 0.f}};
                small_gemm<1024>(lds, (const bf16_t*)(ws + WS_S1), (const bf16_t*)(ws + WS_WO), m0, n0, t2, a1);
                const int r = m0 + wave * 16 + fr;
#pragma unroll
                for (int ct = 0; ct < 2; ++ct) { const int c = n0 + ct * 16 + 4 * fq;
                    const f32x4 xv = *(const f32x4*)(P.in[1] + (size_t)(r - MP) * 1024 + c), gv = *(const f32x4*)(mod + (size_t)batch_of_row(r) * NMOD + 2048 + c);
                    const f32x4 o = xv + gv * a1[ct]; u32x2 w; w.x = pk_bf16(o[0], o[1]); w.y = pk_bf16(o[2], o[3]);
                    *(u32x2*)(xmid + (size_t)r * 1024 + c) = w; }
            }
        }
    }
    xcd_barrier(xbar);
    phase_norm<1>(nullptr, nullptr, xmid, P.in[26], mod, 3072, 4096, (bf16_t*)(ws + WS_S0), nullptr);
    xcd_barrier(xbar);
    for (int rep = 0; rep < REPS(8); ++rep) {
        if (rep) xcd_barrier(xbar);
        pg8::Gemm g{(const bf16_t*)(ws + WS_S0), (const bf16_t*)(ws + WS_WUP), MT, 6144, 1024}; pg8::StaticOrder S; S.init(MT, 6144, G, bid);
        EpiUp E{(bf16_t*)(ws + WS_ACT), P.in[28], P.in[29], P.out + O_Y  , (float*)(ws + WS_UPA), (float*)(ws + WS_UPB), P.out, lds + LDS_STAGE};
        pg8::gemm_phase<EpiUp>(lds, g, S, E);
    }
    xcd_barrier(xbar);
    {
        const float* upa = (const float*)(ws + WS_UPA); const float* upb = (const float*)(ws + WS_UPB);
        const float* wdw = P.in[28]; const float* bdw = P.in[29];
        bf16_t* act = (bf16_t*)(ws + WS_ACT);
        for (int e = bid * NTHREADS + opaque_tid(); e < 56 * 2 * 3072; e += G * NTHREADS) {
            const int c = e % 3072, rr = (e / 3072) & 1, ti = e / 6144, pm = (ti / 7) * 8 + 1 + ti % 7;
            float cv[2];
#pragma unroll
            for (int bj = 0; bj < 2; ++bj) { const int col = bj * 3072 + c;
                const float a0 = upa[((size_t)pm * 2 + 0) * 6144 + col], a1 = upa[((size_t)pm * 2 + 1) * 6144 + col];
                const float b0 = upb[((size_t)(pm - 1) * 2 + 0) * 6144 + col], b1 = upb[((size_t)(pm - 1) * 2 + 1) * 6144 + col];
                const float cur = rr ? a1 : a0, p1 = rr ? a0 : b1, p2 = rr ? b1 : b0;
                cv[bj] = wdw[2 * 6144 + col] * cur + wdw[6144 + col] * p1 + wdw[col] * p2 + bdw[col]; }
            act[((size_t)pm * 256 + rr) * 3072 + c] = (bf16_t)(pk_bf16(gelu_tanh(cv[0]) * cv[1], 0.f) & 0xffffu);
        }
    }
    {
        const float* ups = P.out + O_Y; const float* stf = P.in[5];
        const float* wdw = P.in[28]; const float* bdw = P.in[29];
        bf16_t* act = (bf16_t*)(ws + WS_ACT);
        for (int e = bid * NTHREADS + opaque_tid(); e < MS * 768; e += G * NTHREADS) {
            const int c = (e % 768) * 4, s = e / 768, sb = s >> 3, t = s & 7;
            f32x4 cv[2];
#pragma unroll
            for (int bj = 0; bj < 2; ++bj) { const int col = bj * 3072 + c;
                const f32x4 cur = *(const f32x4*)(ups + (size_t)s * 6144 + col);
                const f32x4 p1 = *(const f32x4*)(t >= 1 ? ups + (size_t)(s - 1) * 6144 + col : stf + ((size_t)sb * 2 + 1) * 6144 + col);
                const f32x4 p2 = *(const f32x4*)(t >= 2 ? ups + (size_t)(s - 2) * 6144 + col : stf + ((size_t)sb * 2 + t) * 6144 + col);
                cv[bj] = *(const f32x4*)(wdw + 2 * 6144 + col) * cur + *(const f32x4*)(wdw + 6144 + col) * p1 + *(const f32x4*)(wdw + col) * p2 + *(const f32x4*)(bdw + col);
                if (t >= 6) *(f32x4*)(P.out + O_FFN_S + ((size_t)sb * 2 + t - 6) * 6144 + col) = cur; }
            u32x2 o; o.x = pk_bf16(gelu_tanh(cv[0][0]) * cv[1][0], gelu_tanh(cv[0][1]) * cv[1][1]); o.y = pk_bf16(gelu_tanh(cv[0][2]) * cv[1][2], gelu_tanh(cv[0][3]) * cv[1][3]);
            *(u32x2*)(act + ((size_t)MP + s) * 3072 + c) = o;
        }
    }
    xcd_barrier(xbar);
    {
        pg8::Gemm g{(const bf16_t*)(ws + WS_ACT), (const bf16_t*)(ws + WS_WDN), MP, 1024, 3072}; pg8::StaticOrder S; S.init(MP, 1024, G, bid);
        EpiRes<true> E{nullptr, xmid, mod, 5120}; pg8::gemm_phase<EpiRes<true>>(lds, g, S, E);
        {
            const int t2 = opaque_tid(), lane = t2 & 63, wave = t2 >> 6, fr = lane & 15, fq = lane >> 4;
            for (int t = bid; t < 256; t += G) {
                const int m0 = MP + (t >> 5) * 128, n0 = (t & 31) * 32;
                f32x4 a1[2] = {{0.f, 0.f, 0.f, 0.f}, {0.f, 0.f, 0.f, 0.f}};
                small_gemm<3072>(lds, (const bf16_t*)(ws + WS_ACT), (const bf16_t*)(ws + WS_WDN), m0, n0, t2, a1);
                const int r = m0 + wave * 16 + fr;
#pragma unroll
                for (int ct = 0; ct < 2; ++ct) { const int c = n0 + ct * 16 + 4 * fq;
                    bf16_t* xp = xmid + (size_t)r * 1024 + c;
                    const u32x2 xw = *(const u32x2*)xp; const f32x4 xv = {bf_lo(xw.x), bf_hi(xw.x), bf_lo(xw.y), bf_hi(xw.y)}, gv = *(const f32x4*)(mod + (size_t)batch_of_row(r) * NMOD + 5120 + c);
                    const f32x4 o = xv + gv * a1[ct]; u32x2 w; w.x = pk_bf16(o[0], o[1]); w.y = pk_bf16(o[2], o[3]);
                    *(u32x2*)xp = w; }
            }
        }
    }
    xcd_barrier(xbar);
    phase_norm<2>(nullptr, nullptr, xmid, P.in[31], nullptr, 0, 0, nullptr, P.out + O_Y);
}

extern "C" void kernel_launch(void* const* d_in, const int* in_sizes, int n_in, void* d_out, int out_size, void* d_ws, size_t ws_size, hipStream_t stream) {
    static int grid_blocks = 0;
    if (grid_blocks == 0) {
        if (n_in != 32 || (size_t)out_size != O_END || ws_size < WS_NEED) { fprintf(stderr, "kernel_launch: unexpected shapes: n_in %d out %d ws %zu (need %zu)\n", n_in, out_size, ws_size, (size_t)WS_NEED); grid_blocks = -1; return; }
        int dev = 0, cus = 0, per_cu = 0;
        hipGetDevice(&dev);
        hipDeviceGetAttribute(&cus, hipDeviceAttributeMultiprocessorCount, dev);
        if (hipFuncSetAttribute((const void*)fwd_megakernel, hipFuncAttributeMaxDynamicSharedMemorySize, LDS_BYTES) != hipSuccess) { fprintf(stderr, "kernel_launch: hipFuncSetAttribute failed\n"); grid_blocks = -1; return; }
        if (hipOccupancyMaxActiveBlocksPerMultiprocessor(&per_cu, (const void*)fwd_megakernel, NTHREADS, LDS_BYTES) != hipSuccess || per_cu < 1) { fprintf(stderr, "kernel_launch: occupancy query gave %d\n", per_cu); per_cu = 1; (void)hipGetLastError(); }
        grid_blocks = cus;
    }
    if (grid_blocks < 0) return;
    Params p{};
    for (int i = 0; i < 32; ++i) p.in[i] = (const float*)d_in[i];
    p.out = (float*)d_out; p.ws = (unsigned char*)d_ws;
    if (hipMemsetAsync((char*)d_ws + WS_BAR, 0, WS_BAR_BYTES, stream) != hipSuccess) { fprintf(stderr, "kernel_launch: memset of barrier words failed\n"); return; }
    void* args[] = {&p};
    hipError_t e = hipLaunchCooperativeKernel((const void*)fwd_megakernel, dim3(grid_blocks), dim3(NTHREADS), args, LDS_BYTES, stream);
    if (e != hipSuccess) fprintf(stderr, "cooperative launch failed: %s (grid %d)\n", hipGetErrorString(e), grid_blocks);
}
```
